# Optimizing an MI355X kernel written in HIP

```python
import jax, jax.numpy as jnp
from jax import lax
import numpy as np

D_MODEL = 1024
BATCH = 32
SEQ = 2048
DEPTH = 2

F32 = jnp.float32
CTX_LEN = 256
GRID_W = 64
BRANCH_WIDTH = D_MODEL // 2
N_BRANCH = 3
POOL_GROUPS = 4
POOL_WINDOWS = (2, 4, 8, 16)
POOL_WIDTH = BRANCH_WIDTH
POOL_GDIM = POOL_WIDTH // POOL_GROUPS
M_HEADS = 4
M_HDIM = BRANCH_WIDTH // M_HEADS
M_WIDTH = M_HEADS * M_HDIM
M_CHUNK = 128
A_HDIM = 64
A_Q_HEADS = BRANCH_WIDTH // A_HDIM
A_KV_HEADS = A_Q_HEADS // 4
A_GROUP = A_Q_HEADS // A_KV_HEADS
A_Q_WIDTH = A_Q_HEADS * A_HDIM
A_KV_WIDTH = A_KV_HEADS * A_HDIM
WINDOW = 128
A_BLOCK = 128
ROPE_BASE = 10000.0
ROPE_PAIRS = A_HDIM // 4
D_FF = ((8 * D_MODEL + 3 * 256 - 1) // (3 * 256)) * 256
SPLIT_SIZES = (POOL_WIDTH, M_WIDTH, M_WIDTH, M_WIDTH, M_WIDTH, 2 * M_HEADS, 2 * M_HEADS,
               A_Q_WIDTH, A_KV_WIDTH, A_KV_WIDTH, N_BRANCH * D_MODEL)
IN_WIDTH = sum(SPLIT_SIZES)
DN_ALPHA = (2 * DEPTH) ** 0.25
DN_BETA = (8 * DEPTH) ** -0.25
LN_EPS = 1e-5

kernel_name = 'hybrid_pool_mlstm_swa_dit_trunk'


def _layer_norm(x, g=None, b=None):
    xf = x.astype(F32)
    mu = jnp.mean(xf, -1, keepdims=True)
    var = jnp.mean(jnp.square(xf - mu), -1, keepdims=True)
    y = (xf - mu) * lax.rsqrt(var + LN_EPS)
    if g is not None:
        y = y * g.astype(F32) + b.astype(F32)
    return y.astype(x.dtype)


def _modulate(x, shift, scale):
    return _layer_norm(x) * (1.0 + scale) + shift


def _post_norm(x, y, g, b):
    return _layer_norm(DN_ALPHA * x + y, g, b)


def _swiglu(h, p):
    return (jax.nn.silu(h @ p['w_ffn_gate']) * (h @ p['w_ffn_up'])) @ p['w_ffn_down']


def _project(h, p):
    B, T, _ = h.shape
    offs = np.cumsum(SPLIT_SIZES)[:-1].tolist()
    (a, qm, km, vm, om, ig, fg, qa, ka, va, gates) = jnp.split(h @ p['w_in'], offs, axis=-1)

    def heads(t):
        return t.reshape(B, T, M_HEADS, M_HDIM).transpose(0, 2, 1, 3).astype(F32)

    m_i = (ig.reshape(B, T, 2, M_HEADS).astype(F32) + p['m_b_i']).transpose(2, 0, 3, 1)
    m_f = jax.nn.log_sigmoid(fg.reshape(B, T, 2, M_HEADS).astype(F32) + p['m_b_f']).transpose(2, 0, 3, 1)
    return {
        'pool': a,
        'm_q': heads(qm), 'm_k': heads(km) * (M_HDIM ** -0.5), 'm_v': heads(vm), 'm_o': om,
        'm_i': m_i, 'm_f': m_f,
        'a_q': qa.reshape(B, T, A_Q_HEADS, A_HDIM),
        'a_k': ka.reshape(B, T, A_KV_HEADS, A_HDIM),
        'a_v': va.reshape(B, T, A_KV_HEADS, A_HDIM),
        'gates': gates,
    }


def _pool_mixer(a, pool_w, pool_scale):
    B, T, _ = a.shape
    af = a.astype(F32)
    csum = jnp.concatenate([jnp.zeros((B, 1, POOL_WIDTH), F32), jnp.cumsum(af, axis=1)], axis=1)
    t = jnp.arange(T)
    outs = []
    for g, w in enumerate(POOL_WINDOWS):
        lo = jnp.clip(t - w // 2, 0, T)
        hi = jnp.clip(t - w // 2 + w, 0, T)
        sl = slice(g * POOL_GDIM, (g + 1) * POOL_GDIM)
        mean = (csum[:, hi, sl] - csum[:, lo, sl]) / (hi - lo).astype(F32)[None, :, None]
        outs.append(mean - af[:, :, sl])
    u = jnp.stack(outs, axis=2).astype(a.dtype)
    u = jnp.einsum('btgc,gcd->btgd', u, pool_w).reshape(B, T, POOL_WIDTH)
    return u * pool_scale


def _mlstm_chunk_step(state, xs):
    C, n, m = state
    q, k, v, ig, lf = xs
    L = q.shape[2]
    b = jnp.cumsum(lf, axis=-1)
    causal = jnp.tril(jnp.ones((L, L), bool))
    log_d = jnp.where(causal, b[..., :, None] - b[..., None, :] + ig[..., None, :], -jnp.inf)
    inter = b + m[..., None]
    m_row = jnp.maximum(inter, jnp.max(log_d, axis=-1))
    s = jnp.einsum('bhjd,bhtd->bhjt', q, k) * jnp.exp(log_d - m_row[..., None])
    w_inter = jnp.exp(inter - m_row)
    num = jnp.einsum('bhjt,bhtv->bhjv', s, v) + w_inter[..., None] * jnp.einsum('bhjd,bhdv->bhjv', q, C)
    nq = jnp.sum(s, axis=-1) + w_inter * jnp.einsum('bhjd,bhd->bhj', q, n)
    den = jnp.maximum(jnp.abs(nq), jnp.exp(-m_row))
    h = num / den[..., None]
    b_last = b[..., -1]
    g = b_last[..., None] - b + ig
    m_new = jnp.maximum(b_last + m, jnp.max(g, axis=-1))
    wk = jnp.exp(g - m_new[..., None])
    decay = jnp.exp(b_last + m - m_new)
    C_new = decay[..., None, None] * C + jnp.einsum('bht,bhtd,bhtv->bhdv', wk, k, v)
    n_new = decay[..., None] * n + jnp.einsum('bht,bhtd->bhd', wk, k)
    return (C_new, n_new, m_new), h


def _mlstm_scan(q, k, v, ig, lf, state):
    B, H, T, d = q.shape
    nc = T // M_CHUNK

    def chunks(a):
        return jnp.moveaxis(a.reshape(a.shape[:2] + (nc, M_CHUNK) + a.shape[3:]), 2, 0)

    state, h = lax.scan(_mlstm_chunk_step, state, (chunks(q), chunks(k), chunks(v), chunks(ig), chunks(lf)))
    return jnp.moveaxis(h, 0, 2).reshape(B, H, T, d), state


def _direction_inputs(pt, direction):
    parts = (pt['m_q'], pt['m_k'], pt['m_v'], pt['m_i'][direction], pt['m_f'][direction])
    if direction == 1:
        return tuple(jnp.flip(a, axis=2) for a in parts)
    return parts


def _mlstm_bidirectional(pl, pc):
    B = pl['m_q'].shape[0]
    zero = (jnp.zeros((B, M_HEADS, M_HDIM, M_HDIM), F32), jnp.zeros((B, M_HEADS, M_HDIM), F32),
            jnp.zeros((B, M_HEADS), F32))
    h_lat, h_ctx = None, None
    for direction in range(2):
        hc, state = _mlstm_scan(*_direction_inputs(pc, direction), zero)
        hl, _ = _mlstm_scan(*_direction_inputs(pl, direction), state)
        if direction == 1:
            hc, hl = jnp.flip(hc, axis=2), jnp.flip(hl, axis=2)
        h_lat = hl if h_lat is None else h_lat + hl
        h_ctx = hc if h_ctx is None else h_ctx + hc
    return h_lat, h_ctx


def _mlstm_readout(h, o, norm_w):
    B, H, T, d = h.shape
    mu = jnp.mean(h, -1, keepdims=True)
    var = jnp.mean(jnp.square(h - mu), -1, keepdims=True)
    hn = ((h - mu) * lax.rsqrt(var + LN_EPS)).transpose(0, 2, 1, 3).reshape(B, T, M_WIDTH)
    return (hn * norm_w.astype(F32) * jax.nn.sigmoid(o.astype(F32))).astype(o.dtype)


def _axial_rope_tables(n_tokens):
    rows = n_tokens // GRID_W
    row = jnp.repeat(jnp.arange(rows, dtype=F32), GRID_W)
    col = jnp.tile(jnp.arange(GRID_W, dtype=F32), rows)
    inv = ROPE_BASE ** (-jnp.arange(ROPE_PAIRS, dtype=F32) / ROPE_PAIRS)
    ang = jnp.concatenate([row[:, None] * inv, col[:, None] * inv], axis=-1)
    return jnp.cos(ang), jnp.sin(ang)


def _apply_axial_rope(x, cos, sin):
    B, T, H, d = x.shape
    xr = x.astype(F32).reshape(B, T, H, 2, 2, ROPE_PAIRS)
    x1, x2 = xr[..., 0, :], xr[..., 1, :]
    c = cos.reshape(T, 1, 2, ROPE_PAIRS)
    s = sin.reshape(T, 1, 2, ROPE_PAIRS)
    out = jnp.stack([x1 * c - x2 * s, x2 * c + x1 * s], axis=-2)
    return out.reshape(B, T, H, d).astype(x.dtype)


def _sink_attend(q, ks, vs, masks, sink):
    scale = A_HDIM ** -0.5
    logits = []
    for k, msk in zip(ks, masks):
        s = jnp.einsum('bqhgd,bkhd->bhgqk', q, k).astype(F32) * scale
        if msk is not None:
            s = jnp.where(msk, s, -jnp.inf)
        logits.append(s)
    B, Q = q.shape[:2]
    logits.append(jnp.broadcast_to(sink.astype(F32)[None, :, :, None, None], (B,) + sink.shape + (Q, 1)))
    p = jax.nn.softmax(jnp.concatenate(logits, axis=-1), axis=-1)
    out, off = None, 0
    for v, s in zip(vs, logits[:-1]):
        nk = s.shape[-1]
        o = jnp.einsum('bhgqk,bkhd->bqhgd', p[..., off:off + nk].astype(v.dtype), v)
        out = o if out is None else out + o
        off += nk
    return out


def _windowed_attention(q, k, v, kc, vc, sink):
    B, T = q.shape[:2]
    nb = T // A_BLOCK
    band = 3 * A_BLOCK
    pad = ((0, 0), (A_BLOCK, A_BLOCK), (0, 0), (0, 0))
    kp, vp = jnp.pad(k, pad), jnp.pad(v, pad)

    def block(i):
        start = i * A_BLOCK
        qb = lax.dynamic_slice_in_dim(q, start, A_BLOCK, axis=1)
        kb = lax.dynamic_slice_in_dim(kp, start, band, axis=1)
        vb = lax.dynamic_slice_in_dim(vp, start, band, axis=1)
        qpos = start + jnp.arange(A_BLOCK)
        kpos = start - A_BLOCK + jnp.arange(band)
        valid = ((jnp.abs(qpos[:, None] - kpos[None, :]) <= WINDOW)
                 & (kpos >= 0)[None, :] & (kpos < T)[None, :])
        return _sink_attend(qb, (kb, kc), (vb, vc), (valid, None), sink)

    out = lax.map(block, jnp.arange(nb))
    return jnp.moveaxis(out, 0, 1).reshape(B, T, A_Q_WIDTH)


def _merge(gates, branch_outs, p):
    B, T, _ = gates.shape
    g = jax.nn.sigmoid(gates.astype(F32)).astype(gates.dtype).reshape(B, T, N_BRANCH, D_MODEL)
    y = None
    for i, u in enumerate(branch_outs):
        yi = g[:, :, i] * (u @ p['w_branch'][i])
        y = yi if y is None else y + yi
    return y @ p['w_out']


def _trunk_layer(x, ctx, mod_x, mod_c, p, cos, sin, last):
    sh1, sc1, g1, sh2, sc2, g2 = jnp.split(mod_x, 6, axis=-1)
    csh1, csc1, cg1, csh2, csc2, cg2 = jnp.split(mod_c, 6, axis=-1)
    B, T, _ = x.shape
    px = _project(_modulate(x, sh1, sc1), p)
    pc = _project(_modulate(ctx, csh1, csc1), p)
    pool_x = _pool_mixer(px['pool'], p['pool_w'], p['pool_scale'])
    h_lat, h_ctx = _mlstm_bidirectional(px, pc)
    mlstm_x = _mlstm_readout(h_lat, px['m_o'], p['m_norm_w'])
    qx = _apply_axial_rope(px['a_q'], cos, sin).reshape(B, T, A_KV_HEADS, A_GROUP, A_HDIM)
    kx = _apply_axial_rope(px['a_k'], cos, sin)
    attn_x = _windowed_attention(qx, kx, px['a_v'], pc['a_k'], pc['a_v'], p['attn_sink'])
    mix_x = _merge(px['gates'], (pool_x, mlstm_x, attn_x), p)
    x = _post_norm(x, g1 * mix_x, p['ln1_g'], p['ln1_b'])
    x = _post_norm(x, g2 * _swiglu(_modulate(x, sh2, sc2), p), p['ln2_g'], p['ln2_b'])
    if not last:
        Bc, Lc, _ = ctx.shape
        pool_c = _pool_mixer(pc['pool'], p['pool_w'], p['pool_scale'])
        mlstm_c = _mlstm_readout(h_ctx, pc['m_o'], p['m_norm_w'])
        qc = pc['a_q'].reshape(Bc, Lc, A_KV_HEADS, A_GROUP, A_HDIM)
        attn_c = _sink_attend(qc, (pc['a_k'],), (pc['a_v'],), (None,), p['attn_sink']).reshape(Bc, Lc, A_Q_WIDTH)
        mix_c = _merge(pc['gates'], (pool_c, mlstm_c, attn_c), p)
        ctx = _post_norm(ctx, cg1 * mix_c, p['ln1_g'], p['ln1_b'])
        ctx = _post_norm(ctx, cg2 * _swiglu(_modulate(ctx, csh2, csc2), p), p['ln2_g'], p['ln2_b'])
    return x, ctx


def setup_inputs(seed: int = 0) -> dict:
    key = jax.random.key(seed)
    ks = jax.random.split(key, 24)
    L = DEPTH

    def nrm(k, shape, s):
        return jax.random.normal(k, shape, F32) * s

    return {
        'x': nrm(ks[0], (BATCH, SEQ, D_MODEL), 1.0),
        'c': nrm(ks[1], (BATCH, D_MODEL), 1.0),
        'ctx': nrm(ks[2], (BATCH, CTX_LEN, D_MODEL), 1.0),
        'c_ctx': nrm(ks[3], (D_MODEL,), 1.0),
        'w_mod': nrm(ks[4], (L, D_MODEL, 6 * D_MODEL), 0.5 * D_MODEL ** -0.5),
        'b_mod': nrm(ks[5], (L, 6 * D_MODEL), 0.01),
        'w_in': nrm(ks[6], (L, D_MODEL, IN_WIDTH), D_MODEL ** -0.5),
        'pool_w': nrm(ks[7], (L, POOL_GROUPS, POOL_GDIM, POOL_GDIM), POOL_GDIM ** -0.5),
        'pool_scale': 1.0 + nrm(ks[8], (L, POOL_WIDTH), 0.02),
        'm_b_i': nrm(ks[9], (L, 2, M_HEADS), 0.1),
        'm_b_f': jnp.linspace(3.0, 6.0, M_HEADS, dtype=F32) + nrm(ks[10], (L, 2, M_HEADS), 0.1),
        'm_norm_w': 1.0 + nrm(ks[11], (L, M_WIDTH), 0.02),
        'attn_sink': nrm(ks[12], (L, A_KV_HEADS, A_GROUP), 0.5),
        'w_branch': nrm(ks[13], (L, N_BRANCH, BRANCH_WIDTH, D_MODEL), BRANCH_WIDTH ** -0.5),
        'w_out': nrm(ks[14], (L, D_MODEL, D_MODEL), DN_BETA * D_MODEL ** -0.5),
        'ln1_g': 1.0 + nrm(ks[15], (L, D_MODEL), 0.02),
        'ln1_b': nrm(ks[16], (L, D_MODEL), 0.02),
        'ln2_g': 1.0 + nrm(ks[17], (L, D_MODEL), 0.02),
        'ln2_b': nrm(ks[18], (L, D_MODEL), 0.02),
        'w_ffn_gate': nrm(ks[19], (L, D_MODEL, D_FF), D_MODEL ** -0.5),
        'w_ffn_up': nrm(ks[20], (L, D_MODEL, D_FF), D_MODEL ** -0.5),
        'w_ffn_down': nrm(ks[21], (L, D_FF, D_MODEL), DN_BETA * D_FF ** -0.5),
    }


def reference(x, c, ctx, c_ctx, w_mod, b_mod, w_in, pool_w, pool_scale, m_b_i, m_b_f, m_norm_w,
              attn_sink, w_branch, w_out, ln1_g, ln1_b, ln2_g, ln2_b, w_ffn_gate, w_ffn_up, w_ffn_down):
    cos, sin = _axial_rope_tables(x.shape[1])
    silu_c = jax.nn.silu(c)
    silu_cc = jax.nn.silu(c_ctx)
    for l in range(DEPTH):
        p = {
            'w_in': w_in[l], 'pool_w': pool_w[l], 'pool_scale': pool_scale[l],
            'm_b_i': m_b_i[l], 'm_b_f': m_b_f[l], 'm_norm_w': m_norm_w[l], 'attn_sink': attn_sink[l],
            'w_branch': w_branch[l], 'w_out': w_out[l],
            'ln1_g': ln1_g[l], 'ln1_b': ln1_b[l], 'ln2_g': ln2_g[l], 'ln2_b': ln2_b[l],
            'w_ffn_gate': w_ffn_gate[l], 'w_ffn_up': w_ffn_up[l], 'w_ffn_down': w_ffn_down[l],
        }
        mod_x = (silu_c @ w_mod[l] + b_mod[l])[:, None, :]
        mod_c = silu_cc @ w_mod[l] + b_mod[l]
        x, ctx = _trunk_layer(x, ctx, mod_x, mod_c, p, cos, sin, l == DEPTH - 1)
    return x
```

```cpp
#include <hip/hip_runtime.h>
#include <hip/hip_cooperative_groups.h>
#include <cstdio>
#include <cstdint>
namespace cg = cooperative_groups;

#define LAS __attribute__((address_space(3)))
typedef unsigned short bf16_t;
typedef short bf16x8 __attribute__((ext_vector_type(8)));
typedef float f32x4 __attribute__((ext_vector_type(4)));
typedef unsigned u32x4 __attribute__((ext_vector_type(4)));
typedef unsigned u32x2 __attribute__((ext_vector_type(2)));

constexpr int D = 1024, NB = 32, T = 2048, CL = 256, DFF = 2816;
constexpr int NLAT = NB * T, NCTX = NB * CL, NTOK = NLAT + NCTX;
constexpr int NG = 2, GB = NB / NG, GLAT = GB * T, GCTX = GB * CL, GTOK = GLAT + GCTX;
constexpr int PW = 6656;
constexpr int INW = 6416;
constexpr int C_POOL = 0, C_QM = 512, C_KM = 1024, C_VM = 1536, C_OM = 2048, C_QA = 2560, C_KA = 3072, C_VA = 3200, C_GATE = 3328, C_IG = 6400, C_FG = 6408;
constexpr int PW2 = 4352, P_POOL = 0, P_OM = 512, P_GATE = 1024;
constexpr float LN_EPS = 1e-5f;
constexpr float DN_ALPHA = 1.41421356237309515f;
constexpr int LDS_BYTES = 155648;

constexpr size_t al256(size_t x) { return (x + 255) & ~(size_t)255; }
constexpr size_t WS_CTL = 0, CTL_BYTES = 32768;
constexpr size_t WS_MOD = 32768;
constexpr size_t WS_ROPE = al256(WS_MOD + (size_t)2 * 33 * 6144 * 4);
constexpr size_t WS_STATS = al256(WS_ROPE + (size_t)2048 * 32 * 8);
constexpr size_t WS_W = al256(WS_STATS + (size_t)NTOK * 8);
constexpr size_t W_IN = 0, W_BR = W_IN + (size_t)PW * D * 2, W_OUT = W_BR + (size_t)3 * D * 512 * 2, W_GU = W_OUT + (size_t)D * D * 2,
                 W_DN = W_GU + (size_t)2 * DFF * D * 2, W_LAYER = W_DN + (size_t)D * DFF * 2;
constexpr size_t WS_CTXX = al256(WS_W + 2 * W_LAYER);
constexpr size_t WS_H = al256(WS_CTXX + (size_t)NCTX * D * 4);
constexpr size_t WS_P = al256(WS_H + (size_t)NTOK * D * 2);
constexpr size_t WS_MQ = al256(WS_P + (size_t)GTOK * PW2 * 2);
constexpr size_t WS_AQ = al256(WS_MQ + (size_t)12 * GTOK * 128 * 2);
constexpr size_t WS_AK = al256(WS_AQ + (size_t)8 * GTOK * 64 * 2);
constexpr size_t WS_AV = al256(WS_AK + (size_t)2 * GTOK * 64 * 2);
constexpr size_t WS_IGF = al256(WS_AV + (size_t)2 * GTOK * 64 * 2);
constexpr size_t WS_U = al256(WS_IGF + (size_t)16 * GTOK * 2);
constexpr size_t WS_Y = al256(WS_U + (size_t)GTOK * 1536 * 2);
constexpr size_t WS_END = al256(WS_Y + (size_t)GTOK * D * 2);
static_assert(WS_P + (size_t)NTOK * DFF * 2 <= WS_U, "ACT overlays P2 and the mixer-input buffers");
static_assert(WS_END <= ((size_t)1 << 30), "workspace map must fit 1 GiB");

__device__ __forceinline__ unsigned f2bf(float f) { unsigned u = __builtin_bit_cast(unsigned, f); return (u + 0x7fffu + ((u >> 16) & 1u)) >> 16; }
__device__ __forceinline__ unsigned pk2(float lo, float hi) { unsigned r; asm("v_cvt_pk_bf16_f32 %0, %1, %2" : "=v"(r) : "v"(lo), "v"(hi)); return r; }
__device__ __forceinline__ float bflo(unsigned w) { return __builtin_bit_cast(float, w << 16); }
__device__ __forceinline__ float bfhi(unsigned w) { return __builtin_bit_cast(float, w & 0xffff0000u); }
__device__ __forceinline__ float bf2f(bf16_t h) { return __builtin_bit_cast(float, (unsigned)h << 16); }
__device__ __forceinline__ int opq(int x) { asm volatile("" : "+v"(x)); return x; }
__device__ __forceinline__ int lane_id() { int r; asm volatile("v_mbcnt_lo_u32_b32 %0, -1, 0\n\tv_mbcnt_hi_u32_b32 %0, -1, %0" : "=v"(r)); return r; }
__device__ __forceinline__ float shx(float v, int o, int lane) { return __builtin_bit_cast(float, __builtin_amdgcn_ds_bpermute((lane ^ o) << 2, __builtin_bit_cast(int, v))); }
__device__ __forceinline__ float shup(float v, int o, int lane) { return __builtin_bit_cast(float, __builtin_amdgcn_ds_bpermute((lane - o) << 2, __builtin_bit_cast(int, v))); }
__device__ __forceinline__ float shidx(float v, int src) { return __builtin_bit_cast(float, __builtin_amdgcn_ds_bpermute(src << 2, __builtin_bit_cast(int, v))); }
__device__ __forceinline__ float wave_sum(float v, int lane) {
#pragma unroll
    for (int o = 1; o < 64; o <<= 1) v += shx(v, o, lane);
    return v;
}
__device__ __forceinline__ int opqs(int x) { asm volatile("" : "+s"(x)); return x; }
typedef float f32x2 __attribute__((ext_vector_type(2)));
__device__ __forceinline__ float max3f(float a, float b, float c) { float r; asm("v_max3_f32 %0, %1, %2, %3" : "=v"(r) : "v"(a), "v"(b), "v"(c)); return r; }
__device__ __forceinline__ float max2f(float a, float b) { float r; asm("v_max_f32_e32 %0, %1, %2" : "=v"(r) : "v"(a), "v"(b)); return r; }
__device__ __forceinline__ float sigmoidf_(float x) { return __builtin_amdgcn_rcpf(1.f + __expf(-x)); }

namespace pg8 {
constexpr int BM = 256, BK = 64, HALF = 128, HTB = HALF * BK * 2, STAGE_BYTES = 8 * HTB, NXCD = 8, WGM = 8;
__device__ __forceinline__ int lds_byte(int r, int c) { const int st = (r >> 4) * 2 + (c >> 5), rr = r & 15, cc = c & 31, ob = rr * 64 + cc * 2; return st * 1024 + (ob ^ (((ob >> 9) & 1) << 5)); }
__device__ __forceinline__ void stage_rc(int b, int& R, int& C) { const int st = b / 1024, sb = b % 1024, swz = sb ^ (((sb >> 9) & 1) << 5); R = (st >> 1) * 16 + swz / 64; C = (st & 1) * 32 + (swz % 64) / 2; }
__device__ __forceinline__ int perm32(int rho) { const int n = rho >> 4, i = rho & 15; return 8 * (i >> 2) + 4 * n + (i & 3); }

struct Unit { int pa, pb, po, br; };

struct Seg { const char* A; const char* Bt; size_t a_tile, b_tile; int nM, nN, nwg, lat_n, a_lat, a_ctx, o_lat, o_ctx, pbmap; };
struct Sched {
    Seg s0, s1; int nseg, G, c;
    __device__ __forceinline__ bool next(int i, Unit& u) const {
        long L = (long)i * G + c; int k = 0;
        if (L >= s0.nwg) { if (nseg < 2) return false; L -= s0.nwg; k = 1; if (L >= s1.nwg) return false; }
        const int nwg = k ? s1.nwg : s0.nwg, nM = k ? s1.nM : s0.nM, nN = k ? s1.nN : s0.nN, lat_n = k ? s1.lat_n : s0.lat_n;
        const int a_lat = k ? s1.a_lat : s0.a_lat, a_ctx = k ? s1.a_ctx : s0.a_ctx, o_lat = k ? s1.o_lat : s0.o_lat, o_ctx = k ? s1.o_ctx : s0.o_ctx, pbmap = k ? s1.pbmap : s0.pbmap;
        u.br = k;
        int wgid = (int)L; { const int q = nwg / NXCD, r = nwg % NXCD, xcd = wgid % NXCD, off = wgid / NXCD; wgid = (xcd < r ? xcd * (q + 1) : r * (q + 1) + (xcd - r) * q) + off; }
        const int nig = WGM * nN, gid = wgid / nig, fm = gid * WGM, gsz = (nM - fm) < WGM ? (nM - fm) : WGM;
        const int pm = fm + ((wgid % nig) % gsz); const int pn = (wgid % nig) / gsz;
        u.pb = pbmap ? (pn < 6 ? pn + 2 : (pn == 6 ? 12 : 25)) : pn;
        if (pm < lat_n) { u.pa = a_lat + pm; u.po = o_lat + pm; } else { u.pa = a_ctx + pm - lat_n; u.po = o_ctx + pm - lat_n; }
        return true;
    }
    __device__ __forceinline__ const char* aptr(const Unit& u) const { return (u.br ? s1.A : s0.A) + (size_t)u.pa * (u.br ? s1.a_tile : s0.a_tile); }
    __device__ __forceinline__ const char* bptr(const Unit& u) const { return (u.br ? s1.Bt : s0.Bt) + (size_t)u.pb * (u.br ? s1.b_tile : s0.b_tile); }
};

template <class Epi, int K, int lda, int ldb>
__device__ __forceinline__ void gemm_phase(LAS unsigned char* lds, const Sched& S, const Epi& E, const int wv) {
    const int tid = opq(wv * 64 + lane_id()), wid = __builtin_amdgcn_readfirstlane(tid >> 6), lane = tid & 63, wr = wid >> 2, wc = wid & 3, fr = lane & 15, fq = lane >> 4;
    const int nt = K / BK;
    unsigned voffA[2], voffB[2];
#pragma unroll
    for (int i = 0; i < 2; ++i) { int R, C; stage_rc(tid * 16 + i * 8192, R, C); const int Rb = (R & ~31) + perm32(R & 31);
        voffA[i] = (unsigned)(R * lda + C) * 2u; voffB[i] = (unsigned)(Rb * ldb + C) * 2u; }
    const size_t kstep = (size_t)(BK * 2);
    const size_t hstepA = (size_t)HALF * lda * 2, hstepB = (size_t)HALF * ldb * 2;
    const unsigned ldsw = (unsigned)wid * 1024u;
    const int aoff = lds_byte(wr * 64 + fr, fq * 8), boff = lds_byte(wc * 32 + fr, fq * 8);
#define PG8_SA(b, h) (((b) * 2 + (h)) * HTB)
#define PG8_SB(b, h) ((4 + (b) * 2 + (h)) * HTB)
#define PG8_STAGE(bufoff, gbase, voff) do { _Pragma("unroll") for (int _i = 0; _i < 2; ++_i) \
        __builtin_amdgcn_global_load_lds((const unsigned*)((const char*)(gbase) + (voff)[_i]), (LAS unsigned*)(lds + (bufoff) + ldsw + _i * 8192), 16, 0, 0); } while (0)
#define PG8_LDA(dst, b, h) do { _Pragma("unroll") for (int m = 0; m < 4; ++m) _Pragma("unroll") for (int k = 0; k < 2; ++k) dst[m][k] = *(const LAS bf16x8*)(lds + PG8_SA(b, h) + aoff + m * 2048 + k * 1024); } while (0)
#define PG8_LDB(dst, b, h) do { _Pragma("unroll") for (int n = 0; n < 2; ++n) _Pragma("unroll") for (int k = 0; k < 2; ++k) dst[n][k] = *(const LAS bf16x8*)(lds + PG8_SB(b, h) + boff + n * 2048 + k * 1024); } while (0)
#define PG8_MMA(ai, bj, At, Bt) do { __builtin_amdgcn_s_setprio(1); _Pragma("unroll") for (int m = 0; m < 4; ++m) _Pragma("unroll") for (int n = 0; n < 2; ++n) _Pragma("unroll") for (int k = 0; k < 2; ++k) \
        acc[ai][bj][m][n] = __builtin_amdgcn_mfma_f32_16x16x32_bf16(Bt[n][k], At[m][k], acc[ai][bj][m][n], 0, 0, 0); __builtin_amdgcn_s_setprio(0); } while (0)
#define PG8_WAIT_V(n) asm volatile("s_waitcnt vmcnt(" #n ")" ::: "memory")
#define PG8_WAIT_L(n) asm volatile("s_waitcnt lgkmcnt(" #n ")" ::: "memory")
#define PG8_BAR __builtin_amdgcn_s_barrier()
#define PG8_SCHED __builtin_amdgcn_sched_barrier(0)
    Unit cur, nxt; int ui = 0;
    if (!S.next(0, cur)) return;
    f32x4 acc[2][2][4][2];
#pragma unroll
    for (int a = 0; a < 2; ++a)
#pragma unroll
        for (int b = 0; b < 2; ++b)
#pragma unroll
            for (int m = 0; m < 4; ++m)
#pragma unroll
                for (int n = 0; n < 2; ++n) acc[a][b][m][n] = (f32x4){0.f, 0.f, 0.f, 0.f};
    bf16x8 At[4][2], B0[2][2], B1[2][2];
    const char* cA = S.aptr(cur); const char* cB = S.bptr(cur);
    PG8_STAGE(PG8_SB(0, 0), cB, voffB); PG8_STAGE(PG8_SB(0, 1), cB + hstepB, voffB); PG8_STAGE(PG8_SA(0, 0), cA, voffA); PG8_STAGE(PG8_SA(0, 1), cA + hstepA, voffA);
    if (wr == 1) PG8_BAR;
    PG8_WAIT_V(2); PG8_BAR;
    PG8_STAGE(PG8_SB(1, 0), cB + kstep, voffB); PG8_STAGE(PG8_SA(1, 0), cA + kstep, voffA); PG8_STAGE(PG8_SB(1, 1), cB + hstepB + kstep, voffB);
    PG8_WAIT_V(6); PG8_BAR;
    for (;;) {
        const bool has_next = S.next(ui + 1, nxt);
        const char* nA = has_next ? S.aptr(nxt) : cA; const char* nB = has_next ? S.bptr(nxt) : cB;
        for (int t = 0; t < nt; t += 2) {
            if constexpr (Epi::HOOK) { if (t == 8 || t == 16) E.hook(acc, cur, t >> 3, wr, wc, fr, fq); }
            const bool last = (t == nt - 2);
            const char* a1 = cA + (size_t)(t + 1) * kstep;
            const char* a2 = last ? nA : cA + (size_t)(t + 2) * kstep; const char* b2 = last ? nB : cB + (size_t)(t + 2) * kstep;
            const char* a3 = a2 + kstep; const char* b3 = b2 + kstep;
            PG8_LDB(B0, 0, 0); PG8_LDB(B1, 0, 1); PG8_SCHED; PG8_LDA(At, 0, 0); PG8_STAGE(PG8_SA(1, 1), a1 + hstepA, voffA);
            PG8_WAIT_V(8); PG8_WAIT_L(0); PG8_BAR; PG8_MMA(0, 0, At, B0); PG8_MMA(0, 1, At, B1); PG8_BAR; PG8_SCHED;
            PG8_LDA(At, 0, 1); PG8_STAGE(PG8_SB(0, 0), b2, voffB); PG8_STAGE(PG8_SB(0, 1), b2 + hstepB, voffB); PG8_STAGE(PG8_SA(0, 0), a2, voffA);
            PG8_WAIT_V(8); PG8_WAIT_L(0); PG8_BAR; PG8_MMA(1, 0, At, B0); PG8_MMA(1, 1, At, B1); PG8_BAR; PG8_SCHED;
            PG8_LDB(B0, 1, 0); PG8_LDB(B1, 1, 1); PG8_SCHED; PG8_LDA(At, 1, 0); PG8_STAGE(PG8_SA(0, 1), a2 + hstepA, voffA);
            PG8_WAIT_V(8); PG8_WAIT_L(0); PG8_BAR; PG8_MMA(0, 0, At, B0); PG8_MMA(0, 1, At, B1); PG8_BAR; PG8_SCHED;
            PG8_LDA(At, 1, 1); PG8_STAGE(PG8_SB(1, 0), b3, voffB); PG8_STAGE(PG8_SB(1, 1), b3 + hstepB, voffB); PG8_STAGE(PG8_SA(1, 0), a3, voffA);
            PG8_WAIT_V(8); PG8_WAIT_L(0); PG8_BAR; PG8_MMA(1, 0, At, B0); PG8_MMA(1, 1, At, B1); PG8_BAR; PG8_SCHED;
        }
        if (wr == 0) PG8_BAR;
        E(acc, cur, wr, wc, fr, fq);
        if (!has_next) break;
#pragma unroll
        for (int a = 0; a < 2; ++a)
#pragma unroll
            for (int b = 0; b < 2; ++b)
#pragma unroll
                for (int m = 0; m < 4; ++m)
#pragma unroll
                    for (int n = 0; n < 2; ++n) acc[a][b][m][n] = (f32x4){0.f, 0.f, 0.f, 0.f};
        cur = nxt; cA = nA; cB = nB; ++ui;
        if (wr == 1) PG8_BAR;
    }
    PG8_WAIT_V(0);
    PG8_BAR;
#undef PG8_SA
#undef PG8_SB
#undef PG8_STAGE
#undef PG8_LDA
#undef PG8_LDB
#undef PG8_MMA
#undef PG8_WAIT_V
#undef PG8_WAIT_L
#undef PG8_BAR
#undef PG8_SCHED
}

struct EpiP {
    static constexpr bool HOOK = false;
    bf16_t* P2; bf16_t* MQ; bf16_t* AQ; bf16_t* AK; bf16_t* AV; bf16_t* IGF;
    __device__ __forceinline__ void operator()(const f32x4 (&acc)[2][2][4][2], const Unit& u, int wr, int wc, int fr_, int fq_) const {
        const int fr = opq(fr_), fq = opq(fq_);
        const int pb = u.pb, row0 = u.po * BM + wr * 64 + fr, cw = wc * 32 + 8 * fq;
        if (pb == 25) {
            if (wc == 0 && fq < 2) {
#pragma unroll
                for (int ai = 0; ai < 2; ++ai)
#pragma unroll
                    for (int m = 0; m < 4; ++m) { bf16_t* gp = IGF + (size_t)(8 * fq) * GTOK + row0 + ai * HALF + m * 16;
#pragma unroll
                        for (int n = 0; n < 2; ++n)
#pragma unroll
                            for (int j = 0; j < 4; ++j) gp[(size_t)(4 * n + j) * GTOK] = (bf16_t)f2bf(acc[ai][0][m][n][j]); }
            }
            return;
        }
        const bool isg = pb >= 13;
        bf16_t* db[2]; int rs;
#pragma unroll
        for (int bj = 0; bj < 2; ++bj) {
            if (pb < 2)       { db[bj] = P2 + P_POOL + pb * 256 + bj * HALF + cw; rs = PW2; }
            else if (pb < 8)  { db[bj] = MQ + (size_t)(((pb - 2) >> 1) * 4 + ((pb - 2) & 1) * 2 + bj) * GTOK * 128 + cw; rs = 128; }
            else if (pb < 10) { db[bj] = P2 + P_OM + (pb - 8) * 256 + bj * HALF + cw; rs = PW2; }
            else if (pb < 12) { db[bj] = AQ + (size_t)((pb - 10) * 4 + bj * 2 + (wc >> 1)) * GTOK * 64 + (wc & 1) * 32 + 8 * fq; rs = 64; }
            else if (pb < 13) { db[bj] = (bj == 0 ? AK : AV) + (size_t)(wc >> 1) * GTOK * 64 + (wc & 1) * 32 + 8 * fq; rs = 64; }
            else              { db[bj] = P2 + P_GATE + (pb - 13) * 256 + bj * HALF + cw; rs = PW2; }
        }
#pragma unroll
        for (int ai = 0; ai < 2; ++ai)
#pragma unroll
            for (int m = 0; m < 4; ++m) { const size_t ro = (size_t)(row0 + ai * HALF + m * 16) * rs;
#pragma unroll
                for (int bj = 0; bj < 2; ++bj) { f32x4 v0 = acc[ai][bj][m][0], v1 = acc[ai][bj][m][1];
                    if (isg) {
#pragma unroll
                        for (int j = 0; j < 4; ++j) { v0[j] = __builtin_amdgcn_exp2f(__builtin_amdgcn_fmed3f(v0[j], -30.f, 30.f) * -1.4426950408889634f);
                                                      v1[j] = __builtin_amdgcn_exp2f(__builtin_amdgcn_fmed3f(v1[j], -30.f, 30.f) * -1.4426950408889634f); }
                        v0 = v0 + 1.f; v1 = v1 + 1.f; }
                    u32x4 w; w.x = pk2(v0[0], v0[1]); w.y = pk2(v0[2], v0[3]); w.z = pk2(v1[0], v1[1]); w.w = pk2(v1[2], v1[3]);
                    *(u32x4*)(db[bj] + ro) = w; } }
    }
};
struct EpiMerge {
    static constexpr bool HOOK = true;
    const bf16_t* P; bf16_t* Y;
    __device__ __forceinline__ void hook(f32x4 (&acc)[2][2][4][2], const Unit& u, int i, int wr, int wc, int fr_, int fq_) const {
        const int fr = opq(fr_), fq = opq(fq_);
        const int row0 = u.po * BM + wr * 64 + fr, col0 = u.pb * BM + wc * 32 + 8 * fq;
        const bf16_t* gbase = P + (size_t)row0 * PW2 + P_GATE + (i - 1) * 1024 + col0;
        u32x4 ga[2][2][2], gb[2][2][2];
#define HK_LOAD(buf, b) do { _Pragma("unroll") for (int mm = 0; mm < 2; ++mm) { const bf16_t* gp = gbase + (size_t)(((b) >> 1) * HALF + (2 * ((b) & 1) + mm) * 16) * PW2; \
            _Pragma("unroll") for (int bj = 0; bj < 2; ++bj) { ga[buf][mm][bj] = *(const u32x4*)(gp + bj * HALF); gb[buf][mm][bj] = *(const u32x4*)(gp + 1024 + bj * HALF); } } } while (0)
#define HK_APPLY(buf, b) do { _Pragma("unroll") for (int mm = 0; mm < 2; ++mm) _Pragma("unroll") for (int bj = 0; bj < 2; ++bj) _Pragma("unroll") for (int j = 0; j < 4; ++j) { \
            const float r0 = bflo(gb[buf][mm][bj][j]) * __builtin_amdgcn_rcpf(bflo(ga[buf][mm][bj][j])); \
            const float r1 = bfhi(gb[buf][mm][bj][j]) * __builtin_amdgcn_rcpf(bfhi(ga[buf][mm][bj][j])); \
            acc[(b) >> 1][bj][2 * ((b) & 1) + mm][j >> 1][(j & 1) * 2] *= r0; acc[(b) >> 1][bj][2 * ((b) & 1) + mm][j >> 1][(j & 1) * 2 + 1] *= r1; } } while (0)
        HK_LOAD(0, 0); __builtin_amdgcn_sched_barrier(0);
        HK_LOAD(1, 1); HK_APPLY(0, 0); __builtin_amdgcn_sched_barrier(0);
        HK_LOAD(0, 2); HK_APPLY(1, 1); __builtin_amdgcn_sched_barrier(0);
        HK_LOAD(1, 3); HK_APPLY(0, 2); __builtin_amdgcn_sched_barrier(0);
        HK_APPLY(1, 3); __builtin_amdgcn_sched_barrier(0);
#undef HK_LOAD
#undef HK_APPLY
    }
    __device__ __forceinline__ void operator()(const f32x4 (&acc)[2][2][4][2], const Unit& u, int wr, int wc, int fr_, int fq_) const {
        const int fr = opq(fr_), fq = opq(fq_);
        const int row0 = u.po * BM + wr * 64 + fr, col0 = u.pb * BM + wc * 32 + 8 * fq;
#pragma unroll
        for (int ai = 0; ai < 2; ++ai) {
            u32x4 g[4][2];
#pragma unroll
            for (int m = 0; m < 4; ++m)
#pragma unroll
                for (int bj = 0; bj < 2; ++bj) g[m][bj] = *(const u32x4*)(P + (size_t)(row0 + ai * HALF + m * 16) * PW2 + P_GATE + 2048 + col0 + bj * HALF);
#pragma unroll
            for (int m = 0; m < 4; ++m)
#pragma unroll
                for (int bj = 0; bj < 2; ++bj) {
                    const f32x4 v0 = acc[ai][bj][m][0], v1 = acc[ai][bj][m][1]; const u32x4 e = g[m][bj];
                    u32x4 w;
                    w.x = pk2(v0[0] * __builtin_amdgcn_rcpf(bflo(e.x)), v0[1] * __builtin_amdgcn_rcpf(bfhi(e.x))); w.y = pk2(v0[2] * __builtin_amdgcn_rcpf(bflo(e.y)), v0[3] * __builtin_amdgcn_rcpf(bfhi(e.y)));
                    w.z = pk2(v1[0] * __builtin_amdgcn_rcpf(bflo(e.z)), v1[1] * __builtin_amdgcn_rcpf(bfhi(e.z))); w.w = pk2(v1[2] * __builtin_amdgcn_rcpf(bflo(e.w)), v1[3] * __builtin_amdgcn_rcpf(bfhi(e.w)));
                    *(u32x4*)(Y + (size_t)(row0 + ai * HALF + m * 16) * D + col0 + bj * HALF) = w; }
        }
    }
};
struct EpiRes {
    static constexpr bool HOOK = false;
    const float* xs_lat; const float* xs_ctx; float* xd_lat; float* xd_ctx; const float* gmod;
    const float* stats; const float* lng; const float* lnb;
    __device__ __forceinline__ void operator()(const f32x4 (&acc)[2][2][4][2], const Unit& u, int wr, int wc, int fr_, int fq_) const {
        const int fr = opq(fr_), fq = opq(fq_);
        const bool lat = u.po < 256; const int b = lat ? (u.po >> 3) : 32;
        const float* src = lat ? xs_lat + (size_t)u.po * 256 * D : xs_ctx + (size_t)(u.po - 256) * 256 * D;
        float* dst = lat ? xd_lat + (size_t)u.po * 256 * D : xd_ctx + (size_t)(u.po - 256) * 256 * D;
        const int col0 = u.pb * BM + wc * 32 + 8 * fq;
        const float* gv = gmod + (size_t)b * 6144 + col0;
        const float2* st = (const float2*)stats + (size_t)u.po * 256 + wr * 64 + fr;
#pragma unroll
        for (int bj = 0; bj < 2; ++bj) {
            f32x4 g[2], lg[2], lb[2];
#pragma unroll
            for (int n = 0; n < 2; ++n) { g[n] = *(const f32x4*)(gv + bj * HALF + 4 * n);
                if (stats) { lg[n] = *(const f32x4*)(lng + col0 + bj * HALF + 4 * n) * DN_ALPHA; lb[n] = *(const f32x4*)(lnb + col0 + bj * HALF + 4 * n) * DN_ALPHA; }
                else { lg[n] = (f32x4){DN_ALPHA, DN_ALPHA, DN_ALPHA, DN_ALPHA}; lb[n] = (f32x4){0.f, 0.f, 0.f, 0.f}; } }
#pragma unroll
            for (int ai = 0; ai < 2; ++ai) {
                f32x4 xv[4][2]; float mu[4], rs[4];
#pragma unroll
                for (int m = 0; m < 4; ++m) { const int rl = ai * HALF + m * 16; const size_t ro = (size_t)(wr * 64 + fr + rl) * D + col0 + bj * HALF;
                    if (stats) { const float2 sv = st[rl]; mu[m] = sv.x; rs[m] = sv.y; } else { mu[m] = 0.f; rs[m] = 1.f; }
#pragma unroll
                    for (int n = 0; n < 2; ++n) xv[m][n] = *(const f32x4*)(src + ro + 4 * n); }
                __builtin_amdgcn_sched_barrier(0);
#pragma unroll
                for (int m = 0; m < 4; ++m) { const int rl = ai * HALF + m * 16; const size_t ro = (size_t)(wr * 64 + fr + rl) * D + col0 + bj * HALF;
#pragma unroll
                    for (int n = 0; n < 2; ++n) *(f32x4*)(dst + ro + 4 * n) = (xv[m][n] - mu[m]) * rs[m] * lg[n] + lb[n] + g[n] * acc[ai][bj][m][n]; }
                __builtin_amdgcn_sched_barrier(0);
            }
        }
    }
};
struct EpiUp {
    static constexpr bool HOOK = false;
    bf16_t* O;
    __device__ __forceinline__ void operator()(const f32x4 (&acc)[2][2][4][2], const Unit& u, int wr, int wc, int fr_, int fq_) const {
        const int fr = opq(fr_), fq = opq(fq_);
        const int row0 = u.po * BM + wr * 64 + fr, col0 = u.pb * HALF + wc * 32 + 8 * fq;
#pragma unroll
        for (int ai = 0; ai < 2; ++ai)
#pragma unroll
            for (int m = 0; m < 4; ++m) {
                float t[8];
#pragma unroll
                for (int n = 0; n < 2; ++n)
#pragma unroll
                    for (int h = 0; h < 2; ++h) {
                        const f32x2 gg = (f32x2){acc[ai][0][m][n][2 * h], acc[ai][0][m][n][2 * h + 1]}, uu = (f32x2){acc[ai][1][m][n][2 * h], acc[ai][1][m][n][2 * h + 1]};
                        const f32x2 ea = gg * (f32x2){-1.4426950408889634f, -1.4426950408889634f};
                        f32x2 e; e.x = __builtin_amdgcn_exp2f(ea.x); e.y = __builtin_amdgcn_exp2f(ea.y);
                        e = e + (f32x2){1.f, 1.f};
                        f32x2 r; r.x = __builtin_amdgcn_rcpf(e.x); r.y = __builtin_amdgcn_rcpf(e.y);
                        const f32x2 o = (gg * uu) * r;
                        t[4 * n + 2 * h] = o.x; t[4 * n + 2 * h + 1] = o.y; }
                u32x4 w; w.x = pk2(t[0], t[1]); w.y = pk2(t[2], t[3]); w.z = pk2(t[4], t[5]); w.w = pk2(t[6], t[7]);
                *(u32x4*)(O + (size_t)(row0 + ai * HALF + m * 16) * DFF + col0) = w; }
    }
};
struct EpiDual {
    static constexpr bool HOOK = false;
    EpiRes r; EpiP p;
    __device__ __forceinline__ void operator()(const f32x4 (&acc)[2][2][4][2], const Unit& u, int wr, int wc, int fr, int fq) const {
        if (u.br == 0) r(acc, u, wr, wc, fr, fq); else p(acc, u, wr, wc, fr, fq);
    }
};
}

struct Args { const float* in[22]; float* out; unsigned char* ws; };
enum { I_X = 0, I_C, I_CTX, I_CCTX, I_WMOD, I_BMOD, I_WIN, I_POOLW, I_POOLS, I_MBI, I_MBF, I_MNORM, I_SINK, I_WBR, I_WOUT, I_LN1G, I_LN1B, I_LN2G, I_LN2B, I_WG, I_WU, I_WD };

__device__ __forceinline__ void transpose_item(const float* W, int K, int N, bf16_t* WT, int ldk, int mode, LAS float* scr, int item, int lane) {
    const int nblk = (N + 31) / 32, kb = item / nblk, nb = item % nblk, k0 = 64 * kb, n0 = 32 * nb;
    const int nn = n0 + (lane & 31);
    float tv[32];
#pragma unroll
    for (int i = 0; i < 32; ++i) { const int kk = 2 * i + (lane >> 5); tv[i] = nn < N ? W[(size_t)(k0 + kk) * N + nn] : 0.f; }
#pragma unroll
    for (int i = 0; i < 32; ++i) { const int kk = 2 * i + (lane >> 5); scr[kk * 33 + (lane & 31)] = tv[i]; }
    asm volatile("s_waitcnt lgkmcnt(0)" ::: "memory");
    const int c = lane & 7;
#pragma unroll
    for (int j = 0; j < 4; ++j) { const int n = (lane >> 3) + 8 * j; const LAS float* s = scr + (8 * c) * 33 + n;
        u32x4 o; o.x = pk2(s[0 * 33], s[1 * 33]); o.y = pk2(s[2 * 33], s[3 * 33]); o.z = pk2(s[4 * 33], s[5 * 33]); o.w = pk2(s[6 * 33], s[7 * 33]);
        const int ng = n0 + n;
        if (ng < N) { const int row = mode == 0 ? ng : (mode == 3 ? (ng < 2560 ? ng : (ng < 2576 ? ng + 3840 : ng - 16)) : ((ng >> 7) * 256 + (ng & 127) + (mode == 2 ? 128 : 0)));
            *(u32x4*)(WT + (size_t)row * ldk + k0 + 8 * c) = o; } }
    asm volatile("s_waitcnt lgkmcnt(0)" ::: "memory");
}

__device__ __forceinline__ void wpb_item(const __attribute__((address_space(4))) Args* a, LAS unsigned char* lds, int it, int tid) {
    unsigned char* ws = a->ws;
    const int l = it >> 5, g = (it >> 3) & 3, n0 = (it & 7) * 128;
        LAS float* pwt = (LAS float*)lds;
        LAS float* wbs = pwt + 128 * 128;
        const float* pw = a->in[I_POOLW] + ((size_t)l * 4 + g) * 128 * 128; const float* ps = a->in[I_POOLS] + l * 512 + g * 128;
        const float* wb0 = a->in[I_WBR] + (size_t)l * 3 * 512 * D + (size_t)(g * 128) * D + n0;
#pragma unroll 4
        for (int e = tid; e < 128 * 128; e += 512) { const int c = e >> 7, d = e & 127; pwt[d * 128 + c] = pw[e] * ps[d]; wbs[e] = wb0[(size_t)(e >> 7) * D + (e & 127)]; }
        __syncthreads();
        const int n = tid & 127, cq = tid >> 7;
        bf16_t* dst = (bf16_t*)(ws + WS_W + l * W_LAYER + W_BR) + (size_t)(n0 + n) * 1536 + g * 128 + cq * 32;
#pragma unroll 1
        for (int cg = 0; cg < 8; ++cg) {
            f32x4 sacc = (f32x4){0.f, 0.f, 0.f, 0.f};
#pragma unroll 8
            for (int d = 0; d < 128; ++d) { const f32x4 pv = *(const LAS f32x4*)(pwt + d * 128 + cq * 32 + cg * 4); sacc += pv * wbs[d * 128 + n]; }
            u32x2 o; o.x = pk2(sacc[0], sacc[1]); o.y = pk2(sacc[2], sacc[3]);
            *(u32x2*)(dst + cg * 4) = o;
        }
        __syncthreads();
}
constexpr int TI_IN = 16 * 201, TI_B = 8 * 32, TI_O = 16 * 32, TI_G = 16 * 88, TI_D = 44 * 32, T_PER_L = TI_IN + 2 * TI_B + TI_O + 2 * TI_G + TI_D;
__device__ __forceinline__ void transpose_dispatch(const __attribute__((address_space(4))) Args* a, LAS float* scr, int it, int lane) {
    unsigned char* ws = a->ws;
    constexpr int PER_L = T_PER_L, I_IN = TI_IN, I_B = TI_B, I_O = TI_O, I_G = TI_G;
    do {
            const int l = it / PER_L; int r = it % PER_L;
            unsigned char* wl = ws + WS_W + l * W_LAYER;
            if (r < I_IN) { transpose_item(a->in[I_WIN] + (size_t)l * D * INW, D, INW, (bf16_t*)(wl + W_IN), D, 3, scr, r, lane); break; } r -= I_IN;
            if (r < I_B) { transpose_item(a->in[I_WBR] + ((size_t)l * 3 + 1) * 512 * D, 512, D, (bf16_t*)(wl + W_BR) + 512, 1536, 0, scr, r, lane); break; } r -= I_B;
            if (r < I_B) { transpose_item(a->in[I_WBR] + ((size_t)l * 3 + 2) * 512 * D, 512, D, (bf16_t*)(wl + W_BR) + 1024, 1536, 0, scr, r, lane); break; } r -= I_B;
            if (r < I_O) { transpose_item(a->in[I_WOUT] + (size_t)l * D * D, D, D, (bf16_t*)(wl + W_OUT), D, 0, scr, r, lane); break; } r -= I_O;
            if (r < I_G) { transpose_item(a->in[I_WG] + (size_t)l * D * DFF, D, DFF, (bf16_t*)(wl + W_GU), D, 1, scr, r, lane); break; } r -= I_G;
            if (r < I_G) { transpose_item(a->in[I_WU] + (size_t)l * D * DFF, D, DFF, (bf16_t*)(wl + W_GU), D, 2, scr, r, lane); break; } r -= I_G;
            transpose_item(a->in[I_WD] + (size_t)l * DFF * D, DFF, D, (bf16_t*)(wl + W_DN), DFF, 0, scr, r, lane);
    } while (0);
}
__device__ __forceinline__ void prologue(const __attribute__((address_space(4))) Args* a, LAS unsigned char* lds, const int wv) {
    const int tid = opq(wv * 64 + lane_id()), lane = tid & 63, wave = __builtin_amdgcn_readfirstlane(tid >> 6);
    unsigned char* ws = a->ws;
    if (blockIdx.x < 192) {
        const int l = blockIdx.x / 96, n = (blockIdx.x % 96) * 64 + (tid & 63), sl = tid >> 6;
        LAS float* s = (LAS float*)lds;
        for (int e = tid; e < 33 * 1024; e += 512) { const float v = e < 32 * 1024 ? a->in[I_C][e] : a->in[I_CCTX][e - 32 * 1024]; s[e] = v * sigmoidf_(v); }
        __syncthreads();
        float acc[33];
#pragma unroll
        for (int b = 0; b < 33; ++b) acc[b] = 0.f;
        const float* wm = a->in[I_WMOD] + (size_t)l * D * 6144 + (size_t)(sl * 128) * 6144 + n;
#pragma unroll 16
        for (int k = 0; k < 128; ++k) { const float w = wm[(size_t)k * 6144];
#pragma unroll
            for (int b = 0; b < 33; ++b) acc[b] += s[b * 1024 + sl * 128 + k] * w; }
        __syncthreads();
#pragma unroll
        for (int b = 0; b < 33; ++b) s[(sl * 33 + b) * 64 + (tid & 63)] = acc[b];
        __syncthreads();
        float* mo = (float*)(ws + WS_MOD) + (size_t)l * 33 * 6144;
        for (int e = tid; e < 33 * 64; e += 512) { const int b = e >> 6, c = e & 63; float r = 0.f;
#pragma unroll
            for (int q = 0; q < 8; ++q) r += s[(q * 33 + b) * 64 + c];
            const int nn = (blockIdx.x % 96) * 64 + c;
            mo[(size_t)b * 6144 + nn] = r + a->in[I_BMOD][l * 6144 + nn]; }
        __syncthreads();
    } else {
        const int it = blockIdx.x - 192;
        if (it < 32) wpb_item(a, lds, it, tid);
    }
    for (int e = blockIdx.x * 512 + tid; e < 2048 * 32; e += gridDim.x * 512) {
        const int t = e >> 5, i = e & 31, p = i & 15; const int pos = i < 16 ? (t >> 6) : (t & 63);
        const int p4 = p & 3; double inv = p4 == 0 ? 1.0 : (p4 == 1 ? 0.5623413251903491 : (p4 == 2 ? 0.31622776601683794 : 0.1778279410038923));
        const int q4 = p >> 2; inv *= q4 == 0 ? 1.0 : (q4 == 1 ? 0.1 : (q4 == 2 ? 0.01 : 0.001));
        const double rev = (double)pos * inv * 0.15915494309189535; const float fr = (float)(rev - floor(rev));
        float2 cs; cs.x = __builtin_amdgcn_cosf(fr); cs.y = __builtin_amdgcn_sinf(fr);
        ((float2*)(ws + WS_ROPE))[e] = cs;
    }
    for (int l = 0; l < 2; ++l) {
        bf16_t* win = (bf16_t*)(ws + WS_W + l * W_LAYER + W_IN);
        for (int e = blockIdx.x * 512 + tid; e < (PW - INW) * D / 8; e += gridDim.x * 512) ((u32x4*)(win + (size_t)INW * D))[e] = (u32x4){0u, 0u, 0u, 0u};
    }
    {
        LAS float* scr = (LAS float*)(lds + 32768 + wave * 12288);
        const int gw = blockIdx.x * 8 + wave;
        const int nslot = gw < 1536 ? 1 : 2;
        for (int sl = 0; sl < nslot; ++sl)
            for (int it = gw < 1536 ? gw : 1536 + sl * 512 + (gw - 1536); it < T_PER_L; it += 2560) transpose_dispatch(a, scr, it, lane);
    }
}
__device__ __forceinline__ void late_weights(const __attribute__((address_space(4))) Args* a, LAS unsigned char* lds, const int wv) {
    const int tid = opq(wv * 64 + lane_id()), lane = tid & 63, wave = __builtin_amdgcn_readfirstlane(tid >> 6);
    const int vb = (int)blockIdx.x - 64;
    if (vb < 0) return;
    if (vb < 32) wpb_item(a, lds, 32 + vb, tid);
    LAS float* scr = (LAS float*)(lds + 32768 + wave * 12288);
    const int gw = vb * 8 + wave;
    const int nslot = gw < 256 ? 1 : 2;
    for (int sl = 0; sl < nslot; ++sl)
        for (int it = gw < 256 ? gw : 256 + sl * 1280 + (gw - 256); it < T_PER_L; it += 2816) transpose_dispatch(a, scr, T_PER_L + it, lane);
}

constexpr int LNR = 4;
__device__ __forceinline__ void ln_pass(int nrows, const float* s_lat, const float* s_ctx, float* d_lat, float* d_ctx,
                                        const float* g, const float* bta, const float* mod, int shoff, bf16_t* H, float* stats, const int wv) {
    const int tid_ = opq(wv * 64 + lane_id()), lane = tid_ & 63, nw = gridDim.x * 8;
    for (int row0 = LNR * (blockIdx.x * 8 + (tid_ >> 6)); row0 < nrows; row0 += LNR * nw) {
        const bool lat = row0 < NLAT;
        const float* sp = lat ? s_lat + (size_t)row0 * D : s_ctx + (size_t)(row0 - NLAT) * D;
        f32x4 v[LNR][4];
#pragma unroll
        for (int r = 0; r < LNR; ++r)
#pragma unroll
            for (int j = 0; j < 4; ++j) v[r][j] = *(const f32x4*)(sp + r * D + j * 256 + lane * 4);
        f32x4 gg[4], bb[4];
        if (g) {
#pragma unroll
            for (int j = 0; j < 4; ++j) { gg[j] = *(const f32x4*)(g + j * 256 + lane * 4); bb[j] = *(const f32x4*)(bta + j * 256 + lane * 4); }
        }
        float mean[LNR], rstd[LNR];
#pragma unroll
        for (int r = 0; r < LNR; ++r) { float s = 0.f;
#pragma unroll
            for (int j = 0; j < 4; ++j) s += (v[r][j][0] + v[r][j][1]) + (v[r][j][2] + v[r][j][3]);
            mean[r] = wave_sum(s, lane) * (1.f / D); float s2 = 0.f;
#pragma unroll
            for (int j = 0; j < 4; ++j) { v[r][j] = v[r][j] - mean[r]; s2 += (v[r][j][0] * v[r][j][0] + v[r][j][1] * v[r][j][1]) + (v[r][j][2] * v[r][j][2] + v[r][j][3] * v[r][j][3]); }
            rstd[r] = 1.f / sqrtf(wave_sum(s2, lane) * (1.f / D) + LN_EPS); }
        if (g) {
            float* dp = lat ? d_lat + (size_t)row0 * D : d_ctx + (size_t)(row0 - NLAT) * D;
#pragma unroll
            for (int r = 0; r < LNR; ++r) { float s = 0.f;
                if (stats && lane == 0) { float2 sv; sv.x = mean[r]; sv.y = rstd[r]; ((float2*)stats)[row0 + r] = sv; }
#pragma unroll
                for (int j = 0; j < 4; ++j) { v[r][j] = v[r][j] * rstd[r] * gg[j] + bb[j]; if (!stats) *(f32x4*)(dp + r * D + j * 256 + lane * 4) = v[r][j]; s += (v[r][j][0] + v[r][j][1]) + (v[r][j][2] + v[r][j][3]); }
                if (H) {
                    mean[r] = wave_sum(s, lane) * (1.f / D); float s2 = 0.f;
#pragma unroll
                    for (int j = 0; j < 4; ++j) { v[r][j] = v[r][j] - mean[r]; s2 += (v[r][j][0] * v[r][j][0] + v[r][j][1] * v[r][j][1]) + (v[r][j][2] * v[r][j][2] + v[r][j][3] * v[r][j][3]); }
                    rstd[r] = 1.f / sqrtf(wave_sum(s2, lane) * (1.f / D) + LN_EPS);
                } }
        }
        if (H) {
            const float* mv = mod + (size_t)(lat ? (row0 >> 11) : 32) * 6144 + shoff;
#pragma unroll
            for (int j = 0; j < 4; ++j) { const f32x4 sh = *(const f32x4*)(mv + j * 256 + lane * 4), sc = *(const f32x4*)(mv + 1024 + j * 256 + lane * 4);
#pragma unroll
                for (int r = 0; r < LNR; ++r) { const f32x4 h = v[r][j] * rstd[r] * (sc + 1.f) + sh;
                    u32x2 w; w.x = pk2(h[0], h[1]); w.y = pk2(h[2], h[3]);
                    *(u32x2*)(H + (size_t)(row0 + r) * D + j * 256 + lane * 4) = w; } }
        }
    }
}

template <int GI>
__device__ __forceinline__ void pool_items(const bf16_t* P, bf16_t* U, int nrows, int gt, int nth) {
    constexpr int W = 2 << GI;
    for (int idx = gt; idx < nrows * 16; idx += nth) {
        const int row = idx >> 4, ch = GI * 16 + (idx & 15);
        int t, Ts;
        if (row < GLAT) { t = row & (T - 1); Ts = T; } else { t = (row - GLAT) & (CL - 1); Ts = CL; }
        const bf16_t* pp = P + (size_t)row * PW2 + P_POOL + ch * 8;
        u32x4 xs[W];
#pragma unroll
        for (int r = 0; r < W; ++r) { const int rr = t - W / 2 + r; const bool ok = rr >= 0 && rr < Ts;
            xs[r] = *(const u32x4*)(pp + (long)(ok ? r - W / 2 : 0) * PW2); if (!ok) xs[r] = (u32x4){0u, 0u, 0u, 0u}; }
        float sm[8];
#pragma unroll
        for (int j = 0; j < 8; ++j) sm[j] = 0.f;
#pragma unroll
        for (int r = 0; r < W; ++r)
#pragma unroll
            for (int j = 0; j < 4; ++j) { sm[2 * j] += bflo(xs[r][j]); sm[2 * j + 1] += bfhi(xs[r][j]); }
        const int lo = max(t - W / 2, 0), hi = min(t - W / 2 + W, Ts);
        const float inv = __builtin_amdgcn_rcpf((float)(hi - lo));
        const u32x4 x = xs[W / 2];
        u32x4 o;
#pragma unroll
        for (int j = 0; j < 4; ++j) o[j] = pk2(sm[2 * j] * inv - bflo(x[j]), sm[2 * j + 1] * inv - bfhi(x[j]));
        *(u32x4*)(U + (size_t)row * 1536 + ch * 8) = o;
    }
}
__device__ __forceinline__ void pool_phase(const bf16_t* P, bf16_t* U, bool with_ctx, const int wv) {
    const int gt = blockIdx.x * 512 + opq(wv * 64 + lane_id()), nth = gridDim.x * 512;
    const int nrows = with_ctx ? GTOK : GLAT;
    pool_items<0>(P, U, nrows, gt, nth); pool_items<1>(P, U, nrows, gt, nth); pool_items<2>(P, U, nrows, gt, nth); pool_items<3>(P, U, nrows, gt, nth);
}

typedef short v4i16_t __attribute__((ext_vector_type(4)));
__device__ __forceinline__ bf16x8 tr_frag(LAS unsigned char* base, int pitch, int krow, int ncol_bytes, int fr) {
    LAS unsigned char* p0 = base + (krow + (fr >> 2)) * pitch + ncol_bytes + 8 * (fr & 3);
    const v4i16_t lo = __builtin_amdgcn_ds_read_tr16_b64_v4i16((LAS v4i16_t*)p0);
    const v4i16_t hi = __builtin_amdgcn_ds_read_tr16_b64_v4i16((LAS v4i16_t*)(p0 + 4 * pitch));
    bf16x8 r; r[0] = lo[0]; r[1] = lo[1]; r[2] = lo[2]; r[3] = lo[3]; r[4] = hi[0]; r[5] = hi[1]; r[6] = hi[2]; r[7] = hi[3]; return r;
}
constexpr int ML_PITCH = 272;
constexpr int ML_R0 = 0, ML_R1 = 128 * ML_PITCH, ML_R2 = 2 * 128 * ML_PITCH, ML_R3 = ML_R2 + 144 * ML_PITCH, ML_GV = ML_R3 + 128 * ML_PITCH;
static_assert(ML_GV + 2 * 2048 <= LDS_BYTES - 64, "mlstm LDS map");

__device__ __forceinline__ void mlstm_gates(LAS float* gv, const float (&ig)[2], const float (&fgv)[2], int lane) {
    float lf[2];
#pragma unroll
    for (int e = 0; e < 2; ++e) { const float f = fgv[e]; lf[e] = f >= 0.f ? -__logf(1.f + __expf(-f)) : f - __logf(1.f + __expf(f)); }
    float x = lf[0] + lf[1];
#pragma unroll
    for (int o = 1; o < 64; o <<= 1) { const float t_ = shup(x, o, lane); if (lane >= o) x += t_; }
    const float b1 = x, b0 = x - lf[1], blast = shidx(x, 63);
    const float a0 = ig[0] - b0, a1 = ig[1] - b1;
    float pm = fmaxf(a0, a1);
#pragma unroll
    for (int o = 1; o < 64; o <<= 1) { const float t_ = shup(pm, o, lane); if (lane >= o) pm = fmaxf(pm, t_); }
    const float pprev = shup(pm, 1, lane);
    const float p0 = lane > 0 ? fmaxf(pprev, a0) : a0;
    const float amax = shidx(pm, 63);
    gv[2 * lane] = b0; gv[2 * lane + 1] = b1; gv[128 + 2 * lane] = a0; gv[128 + 2 * lane + 1] = a1; gv[256 + 2 * lane] = p0; gv[256 + 2 * lane + 1] = pm;
    if (lane == 0) { gv[384] = blast; gv[385] = blast + amax; }
}

__device__ __forceinline__ void mlstm_seq(LAS unsigned char* lds, const bf16_t* MQ, const bf16_t* IGF, bf16_t* Hm, int bl, int head, int dir, const float* mbi, const float* mbf, const int wv) {
    const int tid = opq(wv * 64 + lane_id()), w = __builtin_amdgcn_readfirstlane(tid >> 6), lane = tid & 63, fr = lane & 15, fq = lane >> 4;
    __syncthreads();
    f32x4 Cst[9];
#pragma unroll
    for (int vb = 0; vb < 9; ++vb) Cst[vb] = (f32x4){0.f, 0.f, 0.f, 0.f};
    float mst = 0.f;
    const float bi = mbi[dir * 4 + head], bf_ = mbf[dir * 4 + head];
    const int ip = tid >> 2, seg = tid & 3;
    const int gcol = dir * 4 + head;
    bf16x8 Vones;
#pragma unroll
    for (int j = 0; j < 8; ++j) Vones[j] = fr == 0 ? (short)0x3F80 : (short)0;
#define ML_BASE(ci) ((ci) < 2 ? GLAT + bl * CL + (dir ? 1 - (ci) : (ci)) * 128 : bl * T + (dir ? 15 - ((ci) - 2) : (ci) - 2) * 128)
    u32x4 qv[4], kv[4], vv[4];
    { const bf16_t* rp = MQ + ((size_t)head * GTOK + ML_BASE(0) + (dir ? 127 - ip : ip)) * 128 + seg * 32;
#pragma unroll
      for (int jj = 0; jj < 4; ++jj) { qv[jj] = *(const u32x4*)(rp + 8 * jj); kv[jj] = *(const u32x4*)(rp + (size_t)4 * GTOK * 128 + 8 * jj); vv[jj] = *(const u32x4*)(rp + (size_t)8 * GTOK * 128 + 8 * jj); } }
    if (w == 0) {
        float ig[2], fg[2];
#pragma unroll
        for (int e = 0; e < 2; ++e) { const int i2 = 2 * lane + e; const bf16_t* gp_ = IGF + (size_t)gcol * GTOK + ML_BASE(0) + (dir ? 127 - i2 : i2);
            ig[e] = bf2f(gp_[0]) + bi; fg[e] = bf2f(gp_[(size_t)8 * GTOK]) + bf_; }
        mlstm_gates((LAS float*)(lds + ML_GV), ig, fg, lane);
    }
    __syncthreads();
    for (int ci = 0; ci < 18; ++ci) {
        const int base_row = ML_BASE(ci);
        LAS float* gb = (LAS float*)(lds + ML_GV + (ci & 1) * 2048);
        const float blast = gb[384], gmax = gb[385];
        const float mnew = fmaxf(blast + mst, gmax), decay = __expf(blast + mst - mnew);
        { const float wk = __expf(blast + gb[128 + ip] - mnew) * 0.08838834764831845f;
#pragma unroll
          for (int jj = 0; jj < 4; ++jj) { u32x4 o;
#pragma unroll
            for (int e = 0; e < 4; ++e) o[e] = pk2(bflo(kv[jj][e]) * wk, bfhi(kv[jj][e]) * wk);
            *(LAS u32x4*)(lds + ML_R0 + ip * ML_PITCH + (seg * 32 + 8 * jj) * 2) = qv[jj];
            *(LAS u32x4*)(lds + ML_R1 + ip * ML_PITCH + (seg * 32 + 8 * jj) * 2) = o;
            *(LAS u32x4*)(lds + ML_R3 + ip * ML_PITCH + (seg * 32 + 8 * jj) * 2) = vv[jj]; } }
#pragma unroll
        for (int vb = 0; vb < 9; ++vb) { u32x2 cw; cw.x = pk2(Cst[vb][0], Cst[vb][1]); cw.y = pk2(Cst[vb][2], Cst[vb][3]);
            *(LAS u32x2*)(lds + ML_R2 + (16 * vb + fr) * ML_PITCH + (16 * w + 4 * fq) * 2) = cw; }
        float ign[2] = {0.f, 0.f}, fgn[2] = {0.f, 0.f};
        const int nbase = ML_BASE(ci + 1);
        if (ci + 1 < 18) {
            const bf16_t* rp = MQ + ((size_t)head * GTOK + nbase + (dir ? 127 - ip : ip)) * 128 + seg * 32;
#pragma unroll
            for (int jj = 0; jj < 4; ++jj) { qv[jj] = *(const u32x4*)(rp + 8 * jj); kv[jj] = *(const u32x4*)(rp + (size_t)4 * GTOK * 128 + 8 * jj); vv[jj] = *(const u32x4*)(rp + (size_t)8 * GTOK * 128 + 8 * jj); }
            if (w == 0) {
#pragma unroll
                for (int e = 0; e < 2; ++e) { const int i2 = 2 * lane + e; const bf16_t* gp_ = IGF + (size_t)gcol * GTOK + nbase + (dir ? 127 - i2 : i2);
                    ign[e] = bf2f(gp_[0]) + bi; fgn[e] = bf2f(gp_[(size_t)8 * GTOK]) + bf_; }
            }
        }
        __syncthreads();
        bf16x8 Qf[4];
#pragma unroll
        for (int kk = 0; kk < 4; ++kk) Qf[kk] = *(const LAS bf16x8*)(lds + ML_R0 + (16 * w + fr) * ML_PITCH + (32 * kk + 8 * fq) * 2);
        f32x4 S[8], A2[9];
#pragma unroll
        for (int tb = 0; tb < 8; ++tb) { S[tb] = (f32x4){0.f, 0.f, 0.f, 0.f};
#pragma unroll
            for (int kk = 0; kk < 4; ++kk) { const bf16x8 Kf = *(const LAS bf16x8*)(lds + ML_R1 + (16 * tb + fr) * ML_PITCH + (32 * kk + 8 * fq) * 2);
                S[tb] = __builtin_amdgcn_mfma_f32_16x16x32_bf16(Qf[kk], Kf, S[tb], 0, 0, 0); } }
#pragma unroll
        for (int vb = 0; vb < 9; ++vb) { A2[vb] = (f32x4){0.f, 0.f, 0.f, 0.f};
#pragma unroll
            for (int kk = 0; kk < 4; ++kk) { const bf16x8 Cf = *(const LAS bf16x8*)(lds + ML_R2 + (16 * vb + fr) * ML_PITCH + (32 * kk + 8 * fq) * 2);
                A2[vb] = __builtin_amdgcn_mfma_f32_16x16x32_bf16(Qf[kk], Cf, A2[vb], 0, 0, 0); } }
        float Mj[4], wint[4], bj[4], rowf[4];
#pragma unroll
        for (int i = 0; i < 4; ++i) { const int j = 16 * w + 4 * fq + i; bj[i] = gb[j]; Mj[i] = fmaxf(mst, gb[256 + j]); wint[i] = __expf(mst - Mj[i]); rowf[i] = __expf(mnew - blast - Mj[i]); }
        __syncthreads();
#pragma unroll
        for (int tb = 0; tb < 8; ++tb) { const int t = 16 * tb + fr;
#pragma unroll
            for (int i = 0; i < 4; ++i) { const int j = 16 * w + 4 * fq + i; const float v = t <= j ? S[tb][i] * rowf[i] : 0.f;
                *(LAS bf16_t*)(lds + ML_R0 + j * ML_PITCH + t * 2) = (bf16_t)f2bf(v); } }
        if (ci + 1 < 18 && w == 0) mlstm_gates((LAS float*)(lds + ML_GV + ((ci + 1) & 1) * 2048), ign, fgn, lane);
#pragma unroll
        for (int vb = 0; vb < 9; ++vb) {
#pragma unroll
            for (int i = 0; i < 4; ++i) { A2[vb][i] *= wint[i]; }
            Cst[vb] = Cst[vb] * decay; }
        __syncthreads();
#pragma unroll
        for (int kk = 0; kk < 4; ++kk) {
            const bf16x8 Sf = *(const LAS bf16x8*)(lds + ML_R0 + (16 * w + fr) * ML_PITCH + (32 * kk + 8 * fq) * 2);
            const bf16x8 Kwf = tr_frag(lds + ML_R1, ML_PITCH, 32 * kk + 8 * fq, 32 * w, fr);
#pragma unroll
            for (int vb = 0; vb < 9; ++vb) { const bf16x8 Vf = vb < 8 ? tr_frag(lds + ML_R3, ML_PITCH, 32 * kk + 8 * fq, 32 * vb, fr) : Vones;
                A2[vb] = __builtin_amdgcn_mfma_f32_16x16x32_bf16(Sf, Vf, A2[vb], 0, 0, 0);
                Cst[vb] = __builtin_amdgcn_mfma_f32_16x16x32_bf16(Kwf, Vf, Cst[vb], 0, 0, 0); }
        }
#pragma unroll
        for (int i = 0; i < 4; ++i) {
            const float nq = shidx(A2[8][i], lane & 48);
            const float den = fmaxf(fabsf(nq), __expf(-bj[i] - Mj[i]));
            const float rd = __builtin_amdgcn_rcpf(den);
            const int j = 16 * w + 4 * fq + i;
            bf16_t* hp = Hm + ((size_t)(dir * 4 + head) * GTOK + base_row + (dir ? 127 - j : j)) * 128 + fr;
#pragma unroll
            for (int vb = 0; vb < 8; ++vb) hp[16 * vb] = (bf16_t)f2bf(A2[vb][i] * rd);
        }
        mst = mnew;
        __syncthreads();
    }
#undef ML_BASE
}

constexpr int AT_KP = 144;
constexpr int AT_K = 0, AT_V = 384 * AT_KP;
static_assert(AT_V + 384 * AT_KP <= LDS_BYTES - 64, "attention LDS map");

__device__ __forceinline__ u32x4 rope8(u32x4 own, u32x4 par, const float2* cs, bool second) {
    u32x4 o;
#pragma unroll
    for (int j = 0; j < 4; ++j) { const float2 c0 = cs[2 * j], c1 = cs[2 * j + 1];
        const float s0 = second ? c0.y : -c0.y, s1 = second ? c1.y : -c1.y;
        o[j] = pk2(bflo(own[j]) * c0.x + bflo(par[j]) * s0, bfhi(own[j]) * c1.x + bfhi(par[j]) * s1); }
    return o;
}
__device__ __forceinline__ void attn_unit(LAS unsigned char* lds, const bf16_t* AQ, const bf16_t* AK, const bf16_t* AV, bf16_t* U, int bl, int hk, int qb, bool ctxq, const float* sink, const float2* rope, const int wv) {
    const int tid = opq(wv * 64 + lane_id()), w = __builtin_amdgcn_readfirstlane(tid >> 6), lane = tid & 63, fr = lane & 15, fq = lane >> 4;
    const int g = w >> 1, qh = hk * 4 + g, qoff = (w & 1) * 64;
    const int qrow0 = ctxq ? GLAT + bl * CL + qb * 128 : bl * T + qb * 128;
    bf16x8 Qf[4][2];
#pragma unroll
    for (int qt = 0; qt < 4; ++qt)
#pragma unroll
        for (int kk = 0; kk < 2; ++kk) {
            const bf16_t* qp = AQ + ((size_t)qh * GTOK + qrow0 + qoff + 16 * qt + fr) * 64 + 32 * kk + 8 * fq;
            u32x4 own = *(const u32x4*)qp;
            if (!ctxq) { const u32x4 par = *(const u32x4*)(qp + (fq < 2 ? 16 : -16));
                own = rope8(own, par, rope + (size_t)(qb * 128 + qoff + 16 * qt + fr) * 32 + kk * 16 + (fq & 1) * 8, fq >= 2); }
            Qf[qt][kk] = __builtin_bit_cast(bf16x8, own);
        }
    float mrun[4], lrun[4]; f32x4 O[4][4];
    constexpr float LOG2E = 1.4426950408889634f, C2 = 0.125f * LOG2E;
    const float sk = sink[hk * 4 + g] * LOG2E;
#pragma unroll
    for (int qt = 0; qt < 4; ++qt) { mrun[qt] = sk; lrun[qt] = fq == 0 ? 1.f : 0.f;
#pragma unroll
        for (int dv = 0; dv < 4; ++dv) O[dv][qt] = (f32x4){0.f, 0.f, 0.f, 0.f}; }
    for (int st = ctxq ? 1 : 0; st < 2; ++st) {
        const int nkeys = st == 0 ? 384 : 256;
        const int krow0 = st == 0 ? bl * T + qb * 128 - 128 : GLAT + bl * CL;
        const int rlo = st == 0 ? bl * T : krow0, rhi = st == 0 ? bl * T + T - 1 : krow0 + CL - 1;
        __syncthreads();
#pragma unroll 2
        for (int idx = tid; idx < nkeys * 8; idx += 512) {
            const int r = idx >> 3, ch = idx & 7; const int row = min(max(krow0 + r, rlo), rhi);
            const size_t so = ((size_t)hk * GTOK + row) * 64 + ch * 8;
            u32x4 kown = *(const u32x4*)(AK + so);
            const u32x4 vown = *(const u32x4*)(AV + so);
            if (st == 0) { const u32x4 par = *(const u32x4*)(AK + so + ((ch & 2) ? -16 : 16));
                kown = rope8(kown, par, rope + (size_t)(row & (T - 1)) * 32 + (ch >> 2) * 16 + (ch & 1) * 8, (ch & 2) != 0); }
            *(LAS u32x4*)(lds + AT_K + r * AT_KP + ch * 16) = kown;
            *(LAS u32x4*)(lds + AT_V + r * AT_KP + ch * 16) = vown;
        }
        __syncthreads();
        for (int c = 0; c < nkeys / 64; ++c) {
            if (st == 0 && (64 * c + 63 < qoff || 64 * c > qoff + 63 + 256)) continue;
            if (st == 0 && ((qb == 0 && c < 2) || (qb == 15 && c >= 4))) continue;
            const bool need_mask = st == 0 && !(64 * c >= qoff + 63 && 64 * c + 63 <= qoff + 256);
            f32x4 ST[4][4];
#pragma unroll
            for (int kt = 0; kt < 4; ++kt) {
                bf16x8 Kf[2];
#pragma unroll
                for (int kk = 0; kk < 2; ++kk) Kf[kk] = *(const LAS bf16x8*)(lds + AT_K + (64 * c + 16 * kt + fr) * AT_KP + (32 * kk + 8 * fq) * 2);
#pragma unroll
                for (int qt = 0; qt < 4; ++qt) { ST[kt][qt] = (f32x4){0.f, 0.f, 0.f, 0.f};
#pragma unroll
                    for (int kk = 0; kk < 2; ++kk) ST[kt][qt] = __builtin_amdgcn_mfma_f32_16x16x32_bf16(Kf[kk], Qf[qt][kk], ST[kt][qt], 0, 0, 0); }
            }
            if (need_mask) {
                const bool lower_edge = 64 * c < qoff + 63;
#pragma unroll
                for (int qt = 0; qt < 4; ++qt) { const int qi = qoff + 16 * qt + fr; const int lim = lower_edge ? qi : qi + 256;
#pragma unroll
                    for (int kt = 0; kt < 4; ++kt)
#pragma unroll
                        for (int i = 0; i < 4; ++i) { const int kb = 64 * c + 16 * kt + 4 * fq + i;
                            const bool valid = lower_edge ? (kb >= lim) : (kb <= lim); ST[kt][qt][i] = valid ? ST[kt][qt][i] : -INFINITY; } }
            }
            bf16x8 Pb[2][4];
#pragma unroll
            for (int qt = 0; qt < 4; ++qt) {
                float mx = max3f(ST[0][qt][0], ST[0][qt][1], ST[0][qt][2]);
                mx = max3f(mx, ST[0][qt][3], ST[1][qt][0]); mx = max3f(mx, ST[1][qt][1], ST[1][qt][2]); mx = max3f(mx, ST[1][qt][3], ST[2][qt][0]);
                mx = max3f(mx, ST[2][qt][1], ST[2][qt][2]); mx = max3f(mx, ST[2][qt][3], ST[3][qt][0]); mx = max3f(mx, ST[3][qt][1], ST[3][qt][2]);
                mx = max2f(mx, ST[3][qt][3]);
                mx *= C2;
                mx = max2f(mx, shx(mx, 16, lane)); mx = max2f(mx, shx(mx, 32, lane));
                const float mn = max2f(mrun[qt], mx);
                if (__builtin_amdgcn_ballot_w64(mn != mrun[qt]) != 0ull) {
                    const float alpha = __builtin_amdgcn_exp2f(mrun[qt] - mn);
                    lrun[qt] *= alpha;
#pragma unroll
                    for (int dv = 0; dv < 4; ++dv) O[dv][qt] = O[dv][qt] * alpha;
                    mrun[qt] = mn;
                }
                f32x2 ps2 = (f32x2){0.f, 0.f}; unsigned pw[8];
                const f32x2 c2v = (f32x2){C2, C2}, mnv = (f32x2){mn, mn};
#pragma unroll
                for (int kt = 0; kt < 4; ++kt) {
                    const f32x2 a0 = (f32x2){ST[kt][qt][0], ST[kt][qt][1]} * c2v - mnv, a1 = (f32x2){ST[kt][qt][2], ST[kt][qt][3]} * c2v - mnv;
                    f32x2 q0, q1; q0.x = __builtin_amdgcn_exp2f(a0.x); q0.y = __builtin_amdgcn_exp2f(a0.y); q1.x = __builtin_amdgcn_exp2f(a1.x); q1.y = __builtin_amdgcn_exp2f(a1.y);
                    ps2 += q0; ps2 += q1; pw[2 * kt] = pk2(q0.x, q0.y); pw[2 * kt + 1] = pk2(q1.x, q1.y);
                }
                lrun[qt] += ps2.x + ps2.y;
                u32x4 w0; w0.x = pw[0]; w0.y = pw[1]; w0.z = pw[2]; w0.w = pw[3];
                u32x4 w1; w1.x = pw[4]; w1.y = pw[5]; w1.z = pw[6]; w1.w = pw[7];
                Pb[0][qt] = __builtin_bit_cast(bf16x8, w0); Pb[1][qt] = __builtin_bit_cast(bf16x8, w1);
            }
#pragma unroll
            for (int h = 0; h < 2; ++h)
#pragma unroll
            for (int dv = 0; dv < 4; ++dv) {
                LAS unsigned char* vp = lds + AT_V + (64 * c + 32 * h + 4 * fq + (fr >> 2)) * AT_KP + 32 * dv + 8 * (fr & 3);
                const v4i16_t vlo = __builtin_amdgcn_ds_read_tr16_b64_v4i16((LAS v4i16_t*)vp), vhi = __builtin_amdgcn_ds_read_tr16_b64_v4i16((LAS v4i16_t*)(vp + 16 * AT_KP));
                bf16x8 Vf; Vf[0] = vlo[0]; Vf[1] = vlo[1]; Vf[2] = vlo[2]; Vf[3] = vlo[3]; Vf[4] = vhi[0]; Vf[5] = vhi[1]; Vf[6] = vhi[2]; Vf[7] = vhi[3];
#pragma unroll
                for (int qt = 0; qt < 4; ++qt) O[dv][qt] = __builtin_amdgcn_mfma_f32_16x16x32_bf16(Vf, Pb[h][qt], O[dv][qt], 0, 0, 0);
            }
        }
    }
#pragma unroll
    for (int qt = 0; qt < 4; ++qt) {
        float l = lrun[qt]; l += shx(l, 16, lane); l += shx(l, 32, lane);
        const float rl = 1.f / l;
        bf16_t* op = U + (size_t)(qrow0 + qoff + 16 * qt + fr) * 1536 + 1024 + qh * 64 + 4 * fq;
#pragma unroll
        for (int dv = 0; dv < 4; ++dv) { u32x2 o; o.x = pk2(O[dv][qt][0] * rl, O[dv][qt][1] * rl); o.y = pk2(O[dv][qt][2] * rl, O[dv][qt][3] * rl);
            *(u32x2*)(op + 16 * dv) = o; }
    }
}

__device__ __forceinline__ void readout_phase(const bf16_t* P, const bf16_t* Hm, bf16_t* U, const float* normw, int nrows, const int wv) {
    const int tid_ = opq(wv * 64 + lane_id()), lane = tid_ & 63, nw = gridDim.x * 8;
    const f32x4 w0 = *(const f32x4*)(normw + lane * 8), w1 = *(const f32x4*)(normw + lane * 8 + 4);
    for (int row0 = 2 * (blockIdx.x * 8 + (tid_ >> 6)); row0 < nrows; row0 += 2 * nw) {
        u32x4 h0[2], h1[2], og[2];
#pragma unroll
        for (int r = 0; r < 2; ++r) { const size_t ho = ((size_t)(lane >> 4) * GTOK + row0 + r) * 128 + (lane & 15) * 8;
            h0[r] = *(const u32x4*)(Hm + ho); h1[r] = *(const u32x4*)(Hm + (size_t)4 * GTOK * 128 + ho);
            og[r] = *(const u32x4*)(P + (size_t)(row0 + r) * PW2 + P_OM + lane * 8); }
#pragma unroll
        for (int r = 0; r < 2; ++r) {
            float v[8]; float s = 0.f;
#pragma unroll
            for (int j = 0; j < 4; ++j) { v[2 * j] = bflo(h0[r][j]) + bflo(h1[r][j]); v[2 * j + 1] = bfhi(h0[r][j]) + bfhi(h1[r][j]); s += v[2 * j] + v[2 * j + 1]; }
#pragma unroll
            for (int o = 1; o < 16; o <<= 1) s += shx(s, o, lane);
            const float mu = s * (1.f / 128.f); float s2 = 0.f;
#pragma unroll
            for (int j = 0; j < 8; ++j) { v[j] -= mu; s2 += v[j] * v[j]; }
#pragma unroll
            for (int o = 1; o < 16; o <<= 1) s2 += shx(s2, o, lane);
            const float rstd = 1.f / sqrtf(s2 * (1.f / 128.f) + LN_EPS);
            float o_[8];
#pragma unroll
            for (int j = 0; j < 4; ++j) { o_[2 * j] = sigmoidf_(bflo(og[r][j])); o_[2 * j + 1] = sigmoidf_(bfhi(og[r][j])); }
            u32x4 q;
            q.x = pk2(v[0] * rstd * w0[0] * o_[0], v[1] * rstd * w0[1] * o_[1]); q.y = pk2(v[2] * rstd * w0[2] * o_[2], v[3] * rstd * w0[3] * o_[3]);
            q.z = pk2(v[4] * rstd * w1[0] * o_[4], v[5] * rstd * w1[1] * o_[5]); q.w = pk2(v[6] * rstd * w1[2] * o_[6], v[7] * rstd * w1[3] * o_[7]);
            *(u32x4*)(U + (size_t)(row0 + r) * 1536 + 512 + lane * 8) = q;
        }
    }
}

#define XB_TMO      128
#define XB_XCNT(j)  (256  + 64 * (j))
#define XB_XSUB(j)  (1280 + 64 * (j))
#define XB_XGEN(j)  (2304 + 64 * (j))
#define XB_TOP      3328
#define XB_TOPGEN   3392
#define XCD_BAR_WORDS 3456
#define XB_SPIN_CAP (1u << 18)
__device__ __forceinline__ unsigned xb_ld(unsigned* p)              { return __hip_atomic_load(p, __ATOMIC_RELAXED, __HIP_MEMORY_SCOPE_AGENT); }
__device__ __forceinline__ unsigned xb_add(unsigned* p, unsigned v) { return __hip_atomic_fetch_add(p, v, __ATOMIC_RELAXED, __HIP_MEMORY_SCOPE_AGENT); }
__device__ __forceinline__ unsigned xb_xcc_id() { return (unsigned)__builtin_amdgcn_s_getreg((3 << 11) | 20) & 0xFu; }
#define XB_SPIN(cond, bar) do { unsigned _sp = 0; while (cond) { __builtin_amdgcn_s_sleep(1); \
    if ((++_sp & 255u) == 0u) { if (xb_ld(&(bar)[XB_TMO])) break; if (_sp > XB_SPIN_CAP) { atomicAdd(&(bar)[XB_TMO], 1u); break; } } } } while (0)
__device__ __forceinline__ void xcd_barrier_complete(unsigned* bar, unsigned x, unsigned& nloc, unsigned& nx) {
    const unsigned G = gridDim.x * gridDim.y * gridDim.z;
    unsigned sum, cnt, mine, sp = 0u;
    for (;;) {
        sum = 0u; cnt = 0u; mine = 0u;
#pragma unroll
        for (unsigned j = 0; j < 16; ++j) { const unsigned c = xb_ld(&bar[XB_XCNT(j)]); sum += c; cnt += (c > 0u) ? 1u : 0u; mine = (j == x) ? c : mine; }
        if (sum == G) break;
        __builtin_amdgcn_s_sleep(1);
        if ((++sp & 255u) == 0u) { if (xb_ld(&bar[XB_TMO])) break; if (sp > XB_SPIN_CAP) { atomicAdd(&bar[XB_TMO], 1u); break; } }
    }
    nloc = mine > 0u ? mine : 1u; nx = cnt > 0u ? cnt : 1u;
}
__device__ __forceinline__ void xcd_barrier(unsigned* bar, volatile LAS unsigned* st, const int wv) {
    asm volatile("s_waitcnt vmcnt(0)" ::: "memory");
    __syncthreads();
    if (wv == 0 && lane_id() == 0) {
        const unsigned x = xb_xcc_id();
        __builtin_amdgcn_s_waitcnt(0);
        unsigned nloc = st[0], nx = st[1];
        if (nloc == 0u) { xcd_barrier_complete(bar, x, nloc, nx); st[0] = nloc; st[1] = nx; }
        const unsigned old = xb_add(&bar[XB_XSUB(x)], 1u);
        const unsigned gen = old / nloc;
        if (old + 1u == (gen + 1u) * nloc) {
            __builtin_amdgcn_fence(__ATOMIC_RELEASE, "agent");
            asm volatile("s_waitcnt vmcnt(0)" ::: "memory");
            const unsigned og = xb_add(&bar[XB_TOP], 1u);
            const unsigned tg = og / nx;
            if (og + 1u == (tg + 1u) * nx) xb_add(&bar[XB_TOPGEN], 1u);
            else XB_SPIN(xb_ld(&bar[XB_TOPGEN]) == tg, bar);
            __builtin_amdgcn_fence(__ATOMIC_ACQUIRE, "agent");
            xb_add(&bar[XB_XGEN(x)], 1u);
            asm volatile("s_waitcnt vmcnt(0)" ::: "memory");
        } else {
            XB_SPIN(xb_ld(&bar[XB_XGEN(x)]) == gen, bar);
            __builtin_amdgcn_fence(__ATOMIC_ACQUIRE, "agent");
            asm volatile("s_waitcnt vmcnt(0)" ::: "memory");
        }
    }
    __syncthreads();
}

typedef const __attribute__((address_space(4))) Args* KArgP;
__device__ __forceinline__ KArgP kargs() { KArgP p = (KArgP)__builtin_amdgcn_kernarg_segment_ptr(); asm volatile("" : "+s"(p)); return p; }
#define PHASE_ENV(lv, gv) \
    KArgP a = kargs(); unsigned char* ws = a->ws; const int l = opqs(lv), g = opqs(gv); const bool last = (l == 1); (void)g; (void)last; \
    const int G = gridDim.x, bx = blockIdx.x; (void)G; (void)bx; \
    float* mod = (float*)(ws + WS_MOD); float* ctxx = (float*)(ws + WS_CTXX); (void)ctxx; \
    bf16_t* H = (bf16_t*)(ws + WS_H); bf16_t* P = (bf16_t*)(ws + WS_P); bf16_t* ACT = (bf16_t*)(ws + WS_P); (void)H; (void)P; (void)ACT; \
    bf16_t* U = (bf16_t*)(ws + WS_U); bf16_t* Y = (bf16_t*)(ws + WS_Y); bf16_t* Hm = (bf16_t*)(ws + WS_Y); (void)U; (void)Y; (void)Hm; \
    const unsigned char* wl = ws + WS_W + l * W_LAYER; (void)wl; const float* modl = mod + (size_t)l * 33 * 6144; (void)modl;

__global__ void __launch_bounds__(512, 2) fwd_kernel(Args a_unused) {
    extern __shared__ __attribute__((aligned(16))) unsigned char lds_raw[];
    LAS unsigned char* lds = (LAS unsigned char*)lds_raw;
    cg::grid_group grid = cg::this_grid();
    const int wv = __builtin_amdgcn_readfirstlane(threadIdx.x >> 6);
#define XB_ST ((volatile LAS unsigned*)(lds + LDS_BYTES - 32))
#define GSYNC() do { KArgP a_ = kargs(); xcd_barrier((unsigned*)(a_->ws + WS_CTL) + 4096, XB_ST, wv); } while (0)
    if (wv == 0 && lane_id() < 2) XB_ST[lane_id()] = 0u;
    __syncthreads();
    if (wv == 0 && lane_id() == 0) { KArgP a_ = kargs(); (void)xb_add((unsigned*)(a_->ws + WS_CTL) + 4096 + XB_XCNT(xb_xcc_id()), 1u); }

    { KArgP a = kargs(); prologue(a, lds, wv); }
    { KArgP a_ = kargs(); if (a_->ws == nullptr) grid.sync(); }
    GSYNC();
    { PHASE_ENV(0, 0); ln_pass(NTOK, a->in[I_X], a->in[I_CTX], nullptr, nullptr, nullptr, nullptr, mod, 0, H, nullptr, wv); }
    GSYNC();

    {
            { PHASE_ENV(0, 0);
              pg8::Sched S; S.nseg = 1; S.G = G; S.c = bx; S.s0.A = (const char*)H; S.s0.Bt = (const char*)(wl + W_IN); S.s0.a_tile = (size_t)256 * D * 2; S.s0.b_tile = (size_t)256 * D * 2; S.s0.nM = 144; S.s0.nN = PW / 256; S.s0.nwg = S.s0.nM * S.s0.nN; S.s0.lat_n = 128; S.s0.a_lat = 128 * g; S.s0.a_ctx = 256 + 16 * g; S.s0.o_lat = 0; S.s0.o_ctx = 128; S.s0.pbmap = 0; S.s1 = S.s0;
              pg8::EpiP E{P, (bf16_t*)(ws + WS_MQ), (bf16_t*)(ws + WS_AQ), (bf16_t*)(ws + WS_AK), (bf16_t*)(ws + WS_AV), (bf16_t*)(ws + WS_IGF)};
              pg8::gemm_phase<pg8::EpiP, D, D, D>(lds, S, E, wv); }
            GSYNC();
            { PHASE_ENV(0, 0);
                if (bx < GB * 8) mlstm_seq(lds, (const bf16_t*)(ws + WS_MQ), (const bf16_t*)(ws + WS_IGF), Hm, bx >> 3, (bx >> 1) & 3, bx & 1, a->in[I_MBI] + l * 8, a->in[I_MBF] + l * 8, wv);
                const int nunits = GB * 32 + (last ? 0 : GB * 4);
                unsigned* ctr = (unsigned*)(ws + WS_CTL) + 64 * (1 + l * NG + g);
                const float2* rope = (const float2*)(ws + WS_ROPE);
                LAS unsigned* slot = (LAS unsigned*)(lds + LDS_BYTES - 64);
                for (;;) {
                    __syncthreads();
                    if (wv == 0 && lane_id() == 0) *slot = atomicAdd(ctr, 1u);
                    __syncthreads();
                    const int un = (int)*slot;
                    if (un >= nunits) break;
                    if (un < GB * 32) attn_unit(lds, (const bf16_t*)(ws + WS_AQ), (const bf16_t*)(ws + WS_AK), (const bf16_t*)(ws + WS_AV), U, un >> 5, (un >> 4) & 1, un & 15, false, a->in[I_SINK] + l * 8, rope, wv);
                    else { const int r = un - GB * 32; attn_unit(lds, (const bf16_t*)(ws + WS_AQ), (const bf16_t*)(ws + WS_AK), (const bf16_t*)(ws + WS_AV), U, r >> 2, (r >> 1) & 1, r & 1, true, a->in[I_SINK] + l * 8, rope, wv); }
                }
            }
            GSYNC();
            { PHASE_ENV(0, 0);
              readout_phase(P, Hm, U, a->in[I_MNORM] + l * 512, last ? GLAT : GTOK, wv);
              pool_phase(P, U, !last, wv); }
            GSYNC();
            { PHASE_ENV(0, 0);
              pg8::Sched S; S.nseg = 1; S.G = G; S.c = bx; S.s0.A = (const char*)U; S.s0.Bt = (const char*)(wl + W_BR); S.s0.a_tile = (size_t)256 * 1536 * 2; S.s0.b_tile = (size_t)256 * 1536 * 2; S.s0.nM = last ? 128 : 144; S.s0.nN = 4; S.s0.nwg = S.s0.nM * S.s0.nN; S.s0.lat_n = 128; S.s0.a_lat = 0; S.s0.a_ctx = 128; S.s0.o_lat = 0; S.s0.o_ctx = 128; S.s0.pbmap = 0; S.s1 = S.s0;
              pg8::EpiMerge E{P, Y};
              pg8::gemm_phase<pg8::EpiMerge, 1536, 1536, 1536>(lds, S, E, wv);
              late_weights(a, lds, wv); }
            GSYNC();
    }
    {
            { PHASE_ENV(0, 1);
              const float* xs_lat = l == 0 ? a->in[I_X] : a->out; const float* xs_ctx = l == 0 ? a->in[I_CTX] : ctxx;
              pg8::Sched S; S.nseg = 2; S.G = G; S.c = bx;
              S.s0.A = (const char*)Y; S.s0.Bt = (const char*)(wl + W_OUT); S.s0.a_tile = (size_t)256 * D * 2; S.s0.b_tile = (size_t)256 * D * 2; S.s0.nM = last ? 128 : 144; S.s0.nN = 4; S.s0.nwg = S.s0.nM * S.s0.nN;
              S.s0.lat_n = 128; S.s0.a_lat = 0; S.s0.a_ctx = 128; S.s0.o_lat = 0; S.s0.o_ctx = 256; S.s0.pbmap = 0;
              S.s1.A = (const char*)H; S.s1.Bt = (const char*)(wl + W_IN); S.s1.a_tile = (size_t)256 * D * 2; S.s1.b_tile = (size_t)256 * D * 2; S.s1.nM = 144; S.s1.nN = PW / 256; S.s1.nwg = S.s1.nM * S.s1.nN;
              S.s1.lat_n = 128; S.s1.a_lat = 128; S.s1.a_ctx = 256 + 16; S.s1.o_lat = 0; S.s1.o_ctx = 128; S.s1.pbmap = 0;
              pg8::EpiDual E{pg8::EpiRes{xs_lat, xs_ctx, a->out, ctxx, modl + 2048, l == 0 ? nullptr : (const float*)(ws + WS_STATS), a->in[I_LN2G], a->in[I_LN2B]},
                             pg8::EpiP{P, (bf16_t*)(ws + WS_MQ), (bf16_t*)(ws + WS_AQ), (bf16_t*)(ws + WS_AK), (bf16_t*)(ws + WS_AV), (bf16_t*)(ws + WS_IGF)}};
              pg8::gemm_phase<pg8::EpiDual, D, D, D>(lds, S, E, wv); }
            GSYNC();
            { PHASE_ENV(0, 1);
                if (bx < GB * 8) mlstm_seq(lds, (const bf16_t*)(ws + WS_MQ), (const bf16_t*)(ws + WS_IGF), Hm, bx >> 3, (bx >> 1) & 3, bx & 1, a->in[I_MBI] + l * 8, a->in[I_MBF] + l * 8, wv);
                const int nunits = GB * 32 + (last ? 0 : GB * 4);
                unsigned* ctr = (unsigned*)(ws + WS_CTL) + 64 * (1 + l * NG + g);
                const float2* rope = (const float2*)(ws + WS_ROPE);
                LAS unsigned* slot = (LAS unsigned*)(lds + LDS_BYTES - 64);
                for (;;) {
                    __syncthreads();
                    if (wv == 0 && lane_id() == 0) *slot = atomicAdd(ctr, 1u);
                    __syncthreads();
                    const int un = (int)*slot;
                    if (un >= nunits) break;
                    if (un < GB * 32) attn_unit(lds, (const bf16_t*)(ws + WS_AQ), (const bf16_t*)(ws + WS_AK), (const bf16_t*)(ws + WS_AV), U, un >> 5, (un >> 4) & 1, un & 15, false, a->in[I_SINK] + l * 8, rope, wv);
                    else { const int r = un - GB * 32; attn_unit(lds, (const bf16_t*)(ws + WS_AQ), (const bf16_t*)(ws + WS_AK), (const bf16_t*)(ws + WS_AV), U, r >> 2, (r >> 1) & 1, r & 1, true, a->in[I_SINK] + l * 8, rope, wv); }
                }
            }
            GSYNC();
            { PHASE_ENV(0, 1);
              readout_phase(P, Hm, U, a->in[I_MNORM] + l * 512, last ? GLAT : GTOK, wv);
              pool_phase(P, U, !last, wv); }
            GSYNC();
            { PHASE_ENV(0, 1);
              pg8::Sched S; S.nseg = 1; S.G = G; S.c = bx; S.s0.A = (const char*)U; S.s0.Bt = (const char*)(wl + W_BR); S.s0.a_tile = (size_t)256 * 1536 * 2; S.s0.b_tile = (size_t)256 * 1536 * 2; S.s0.nM = last ? 128 : 144; S.s0.nN = 4; S.s0.nwg = S.s0.nM * S.s0.nN; S.s0.lat_n = 128; S.s0.a_lat = 0; S.s0.a_ctx = 128; S.s0.o_lat = 0; S.s0.o_ctx = 128; S.s0.pbmap = 0; S.s1 = S.s0;
              pg8::EpiMerge E{P, Y};
              pg8::gemm_phase<pg8::EpiMerge, 1536, 1536, 1536>(lds, S, E, wv); }
            GSYNC();
            { PHASE_ENV(0, 1);
              const float* xs_lat = l == 0 ? a->in[I_X] : a->out; const float* xs_ctx = l == 0 ? a->in[I_CTX] : ctxx;
              pg8::Sched S; S.nseg = 1; S.G = G; S.c = bx; S.s0.A = (const char*)Y; S.s0.Bt = (const char*)(wl + W_OUT); S.s0.a_tile = (size_t)256 * D * 2; S.s0.b_tile = (size_t)256 * D * 2; S.s0.nM = last ? 128 : 144; S.s0.nN = 4; S.s0.nwg = S.s0.nM * S.s0.nN; S.s0.lat_n = 128; S.s0.a_lat = 0; S.s0.a_ctx = 128; S.s0.o_lat = 128 * g; S.s0.o_ctx = 256 + 16 * g; S.s0.pbmap = 0; S.s1 = S.s0;
              pg8::EpiRes E{xs_lat, xs_ctx, a->out, ctxx, modl + 2048, l == 0 ? nullptr : (const float*)(ws + WS_STATS), a->in[I_LN2G], a->in[I_LN2B]};
              pg8::gemm_phase<pg8::EpiRes, D, D, D>(lds, S, E, wv); }
            GSYNC();
    }
    {
        { PHASE_ENV(0, 0);
          ln_pass(last ? NLAT : NTOK, a->out, ctxx, a->out, ctxx, a->in[I_LN1G] + l * D, a->in[I_LN1B] + l * D, modl, 3072, H, (float*)(ws + WS_STATS), wv); }
        GSYNC();
        { PHASE_ENV(0, 0);
          pg8::Sched S; S.nseg = 1; S.G = G; S.c = bx; S.s0.A = (const char*)H; S.s0.Bt = (const char*)(wl + W_GU); S.s0.a_tile = (size_t)256 * D * 2; S.s0.b_tile = (size_t)256 * D * 2; S.s0.nM = last ? 256 : 288; S.s0.nN = 22; S.s0.nwg = S.s0.nM * S.s0.nN; S.s0.lat_n = 1 << 20; S.s0.a_lat = 0; S.s0.a_ctx = 0; S.s0.o_lat = 0; S.s0.o_ctx = 0; S.s0.pbmap = 0; S.s1 = S.s0;
          pg8::EpiUp E{ACT};
          pg8::gemm_phase<pg8::EpiUp, D, D, D>(lds, S, E, wv); }
        GSYNC();
        { PHASE_ENV(0, 0);
          pg8::Sched S; S.nseg = 1; S.G = G; S.c = bx; S.s0.A = (const char*)ACT; S.s0.Bt = (const char*)(wl + W_DN); S.s0.a_tile = (size_t)256 * DFF * 2; S.s0.b_tile = (size_t)256 * DFF * 2; S.s0.nM = last ? 256 : 288; S.s0.nN = 4; S.s0.nwg = S.s0.nM * S.s0.nN; S.s0.lat_n = 1 << 20; S.s0.a_lat = 0; S.s0.a_ctx = 0; S.s0.o_lat = 0; S.s0.o_ctx = 0; S.s0.pbmap = 0; S.s1 = S.s0;
          pg8::EpiRes E{a->out, ctxx, a->out, ctxx, modl + 5120, (const float*)(ws + WS_STATS), a->in[I_LN1G] + l * D, a->in[I_LN1B] + l * D};
          pg8::gemm_phase<pg8::EpiRes, DFF, DFF, DFF>(lds, S, E, wv); }
        GSYNC();
        { PHASE_ENV(0, 0);
          ln_pass(last ? NLAT : NTOK, a->out, ctxx, a->out, ctxx, a->in[I_LN2G] + l * D, a->in[I_LN2B] + l * D, last ? nullptr : modl + (size_t)33 * 6144, 0, last ? nullptr : H, last ? nullptr : (float*)(ws + WS_STATS), wv); }
    }
    GSYNC();
    {
            { PHASE_ENV(1, 0);
              pg8::Sched S; S.nseg = 2; S.G = G; S.c = bx; S.s0.A = (const char*)H; S.s0.Bt = (const char*)(wl + W_IN); S.s0.a_tile = (size_t)256 * D * 2; S.s0.b_tile = (size_t)256 * D * 2; S.s0.nM = 128; S.s0.nN = PW / 256; S.s0.nwg = S.s0.nM * S.s0.nN;
              S.s0.lat_n = 128; S.s0.a_lat = 0; S.s0.a_ctx = 256; S.s0.o_lat = 0; S.s0.o_ctx = 128; S.s0.pbmap = 0;
              S.s1 = S.s0; S.s1.nM = 16; S.s1.nN = 8; S.s1.nwg = 128; S.s1.lat_n = 0; S.s1.pbmap = 1;
              pg8::EpiP E{P, (bf16_t*)(ws + WS_MQ), (bf16_t*)(ws + WS_AQ), (bf16_t*)(ws + WS_AK), (bf16_t*)(ws + WS_AV), (bf16_t*)(ws + WS_IGF)};
              pg8::gemm_phase<pg8::EpiP, D, D, D>(lds, S, E, wv); }
            GSYNC();
            { PHASE_ENV(1, 0);
                if (bx < GB * 8) mlstm_seq(lds, (const bf16_t*)(ws + WS_MQ), (const bf16_t*)(ws + WS_IGF), Hm, bx >> 3, (bx >> 1) & 3, bx & 1, a->in[I_MBI] + l * 8, a->in[I_MBF] + l * 8, wv);
                const int nunits = GB * 32 + (last ? 0 : GB * 4);
                unsigned* ctr = (unsigned*)(ws + WS_CTL) + 64 * (1 + l * NG + g);
                const float2* rope = (const float2*)(ws + WS_ROPE);
                LAS unsigned* slot = (LAS unsigned*)(lds + LDS_BYTES - 64);
                for (;;) {
                    __syncthreads();
                    if (wv == 0 && lane_id() == 0) *slot = atomicAdd(ctr, 1u);
                    __syncthreads();
                    const int un = (int)*slot;
                    if (un >= nunits) break;
                    if (un < GB * 32) attn_unit(lds, (const bf16_t*)(ws + WS_AQ), (const bf16_t*)(ws + WS_AK), (const bf16_t*)(ws + WS_AV), U, un >> 5, (un >> 4) & 1, un & 15, false, a->in[I_SINK] + l * 8, rope, wv);
                    else { const int r = un - GB * 32; attn_unit(lds, (const bf16_t*)(ws + WS_AQ), (const bf16_t*)(ws + WS_AK), (const bf16_t*)(ws + WS_AV), U, r >> 2, (r >> 1) & 1, r & 1, true, a->in[I_SINK] + l * 8, rope, wv); }
                }
            }
            GSYNC();
            { PHASE_ENV(1, 0);
              readout_phase(P, Hm, U, a->in[I_MNORM] + l * 512, last ? GLAT : GTOK, wv);
              pool_phase(P, U, !last, wv); }
            GSYNC();
            { PHASE_ENV(1, 0);
              pg8::Sched S; S.nseg = 1; S.G = G; S.c = bx; S.s0.A = (const char*)U; S.s0.Bt = (const char*)(wl + W_BR); S.s0.a_tile = (size_t)256 * 1536 * 2; S.s0.b_tile = (size_t)256 * 1536 * 2; S.s0.nM = last ? 128 : 144; S.s0.nN = 4; S.s0.nwg = S.s0.nM * S.s0.nN; S.s0.lat_n = 128; S.s0.a_lat = 0; S.s0.a_ctx = 128; S.s0.o_lat = 0; S.s0.o_ctx = 128; S.s0.pbmap = 0; S.s1 = S.s0;
              pg8::EpiMerge E{P, Y};
              pg8::gemm_phase<pg8::EpiMerge, 1536, 1536, 1536>(lds, S, E, wv); }
            GSYNC();
    }
    {
            { PHASE_ENV(1, 0);
              pg8::Sched S; S.nseg = 1; S.G = G; S.c = bx; S.s0.A = (const char*)Y; S.s0.Bt = (const char*)(wl + W_OUT); S.s0.a_tile = (size_t)256 * D * 2; S.s0.b_tile = (size_t)256 * D * 2; S.s0.nM = 128; S.s0.nN = 4; S.s0.nwg = S.s0.nM * S.s0.nN;
              S.s0.lat_n = 128; S.s0.a_lat = 0; S.s0.a_ctx = 128; S.s0.o_lat = 0; S.s0.o_ctx = 256; S.s0.pbmap = 0; S.s1 = S.s0;
              pg8::EpiRes E{a->out, ctxx, a->out, ctxx, modl + 2048, (const float*)(ws + WS_STATS), a->in[I_LN2G], a->in[I_LN2B]};
              pg8::gemm_phase<pg8::EpiRes, D, D, D>(lds, S, E, wv); }
            GSYNC();
            { PHASE_ENV(1, 1);
              pg8::Sched S; S.nseg = 2; S.G = G; S.c = bx; S.s0.A = (const char*)H; S.s0.Bt = (const char*)(wl + W_IN); S.s0.a_tile = (size_t)256 * D * 2; S.s0.b_tile = (size_t)256 * D * 2; S.s0.nM = 128; S.s0.nN = PW / 256; S.s0.nwg = S.s0.nM * S.s0.nN;
              S.s0.lat_n = 128; S.s0.a_lat = 128; S.s0.a_ctx = 256 + 16; S.s0.o_lat = 0; S.s0.o_ctx = 128; S.s0.pbmap = 0;
              S.s1 = S.s0; S.s1.nM = 16; S.s1.nN = 8; S.s1.nwg = 128; S.s1.lat_n = 0; S.s1.pbmap = 1;
              pg8::EpiP E{P, (bf16_t*)(ws + WS_MQ), (bf16_t*)(ws + WS_AQ), (bf16_t*)(ws + WS_AK), (bf16_t*)(ws + WS_AV), (bf16_t*)(ws + WS_IGF)};
              pg8::gemm_phase<pg8::EpiP, D, D, D>(lds, S, E, wv); }
            GSYNC();
            { PHASE_ENV(1, 1);
                if (bx < GB * 8) mlstm_seq(lds, (const bf16_t*)(ws + WS_MQ), (const bf16_t*)(ws + WS_IGF), Hm, bx >> 3, (bx >> 1) & 3, bx & 1, a->in[I_MBI] + l * 8, a->in[I_MBF] + l * 8, wv);
                const int nunits = GB * 32 + (last ? 0 : GB * 4);
                unsigned* ctr = (unsigned*)(ws + WS_CTL) + 64 * (1 + l * NG + g);
                const float2* rope = (const float2*)(ws + WS_ROPE);
                LAS unsigned* slot = (LAS unsigned*)(lds + LDS_BYTES - 64);
                for (;;) {
                    __syncthreads();
                    if (wv == 0 && lane_id() == 0) *slot = atomicAdd(ctr, 1u);
                    __syncthreads();
                    const int un = (int)*slot;
                    if (un >= nunits) break;
                    if (un < GB * 32) attn_unit(lds, (const bf16_t*)(ws + WS_AQ), (const bf16_t*)(ws + WS_AK), (const bf16_t*)(ws + WS_AV), U, un >> 5, (un >> 4) & 1, un & 15, false, a->in[I_SINK] + l * 8, rope, wv);
                    else { const int r = un - GB * 32; attn_unit(lds, (const bf16_t*)(ws + WS_AQ), (const bf16_t*)(ws + WS_AK), (const bf16_t*)(ws + WS_AV), U, r >> 2, (r >> 1) & 1, r & 1, true, a->in[I_SINK] + l * 8, rope, wv); }
                }
            }
            GSYNC();
            { PHASE_ENV(1, 1);
              readout_phase(P, Hm, U, a->in[I_MNORM] + l * 512, last ? GLAT : GTOK, wv);
              pool_phase(P, U, !last, wv); }
            GSYNC();
            { PHASE_ENV(1, 1);
              pg8::Sched S; S.nseg = 1; S.G = G; S.c = bx; S.s0.A = (const char*)U; S.s0.Bt = (const char*)(wl + W_BR); S.s0.a_tile = (size_t)256 * 1536 * 2; S.s0.b_tile = (size_t)256 * 1536 * 2; S.s0.nM = last ? 128 : 144; S.s0.nN = 4; S.s0.nwg = S.s0.nM * S.s0.nN; S.s0.lat_n = 128; S.s0.a_lat = 0; S.s0.a_ctx = 128; S.s0.o_lat = 0; S.s0.o_ctx = 128; S.s0.pbmap = 0; S.s1 = S.s0;
              pg8::EpiMerge E{P, Y};
              pg8::gemm_phase<pg8::EpiMerge, 1536, 1536, 1536>(lds, S, E, wv); }
            GSYNC();
            { PHASE_ENV(1, 1);
              const float* xs_lat = l == 0 ? a->in[I_X] : a->out; const float* xs_ctx = l == 0 ? a->in[I_CTX] : ctxx;
              pg8::Sched S; S.nseg = 1; S.G = G; S.c = bx; S.s0.A = (const char*)Y; S.s0.Bt = (const char*)(wl + W_OUT); S.s0.a_tile = (size_t)256 * D * 2; S.s0.b_tile = (size_t)256 * D * 2; S.s0.nM = last ? 128 : 144; S.s0.nN = 4; S.s0.nwg = S.s0.nM * S.s0.nN; S.s0.lat_n = 128; S.s0.a_lat = 0; S.s0.a_ctx = 128; S.s0.o_lat = 128 * g; S.s0.o_ctx = 256 + 16 * g; S.s0.pbmap = 0; S.s1 = S.s0;
              pg8::EpiRes E{xs_lat, xs_ctx, a->out, ctxx, modl + 2048, l == 0 ? nullptr : (const float*)(ws + WS_STATS), a->in[I_LN2G], a->in[I_LN2B]};
              pg8::gemm_phase<pg8::EpiRes, D, D, D>(lds, S, E, wv); }
            GSYNC();
    }
    {
        { PHASE_ENV(1, 0);
          ln_pass(last ? NLAT : NTOK, a->out, ctxx, a->out, ctxx, a->in[I_LN1G] + l * D, a->in[I_LN1B] + l * D, modl, 3072, H, (float*)(ws + WS_STATS), wv); }
        GSYNC();
        { PHASE_ENV(1, 0);
          pg8::Sched S; S.nseg = 1; S.G = G; S.c = bx; S.s0.A = (const char*)H; S.s0.Bt = (const char*)(wl + W_GU); S.s0.a_tile = (size_t)256 * D * 2; S.s0.b_tile = (size_t)256 * D * 2; S.s0.nM = last ? 256 : 288; S.s0.nN = 22; S.s0.nwg = S.s0.nM * S.s0.nN; S.s0.lat_n = 1 << 20; S.s0.a_lat = 0; S.s0.a_ctx = 0; S.s0.o_lat = 0; S.s0.o_ctx = 0; S.s0.pbmap = 0; S.s1 = S.s0;
          pg8::EpiUp E{ACT};
          pg8::gemm_phase<pg8::EpiUp, D, D, D>(lds, S, E, wv); }
        GSYNC();
        { PHASE_ENV(1, 0);
          pg8::Sched S; S.nseg = 1; S.G = G; S.c = bx; S.s0.A = (const char*)ACT; S.s0.Bt = (const char*)(wl + W_DN); S.s0.a_tile = (size_t)256 * DFF * 2; S.s0.b_tile = (size_t)256 * DFF * 2; S.s0.nM = last ? 256 : 288; S.s0.nN = 4; S.s0.nwg = S.s0.nM * S.s0.nN; S.s0.lat_n = 1 << 20; S.s0.a_lat = 0; S.s0.a_ctx = 0; S.s0.o_lat = 0; S.s0.o_ctx = 0; S.s0.pbmap = 0; S.s1 = S.s0;
          pg8::EpiRes E{a->out, ctxx, a->out, ctxx, modl + 5120, (const float*)(ws + WS_STATS), a->in[I_LN1G] + l * D, a->in[I_LN1B] + l * D};
          pg8::gemm_phase<pg8::EpiRes, DFF, DFF, DFF>(lds, S, E, wv); }
        GSYNC();
        { PHASE_ENV(1, 0);
          ln_pass(last ? NLAT : NTOK, a->out, ctxx, a->out, ctxx, a->in[I_LN2G] + l * D, a->in[I_LN2B] + l * D, last ? nullptr : modl + (size_t)33 * 6144, 0, last ? nullptr : H, last ? nullptr : (float*)(ws + WS_STATS), wv); }
    }
}


extern "C" void kernel_launch(void* const* d_in, const int* in_sizes, int n_in, void* d_out, int out_size, void* d_ws, size_t ws_size, hipStream_t stream) {
    static int grid = 0;
    if (grid == 0) {
        if (n_in != 22 || ws_size < WS_END) { fprintf(stderr, "kernel_launch: unexpected n_in %d / ws %zu (need %zu)\n", n_in, ws_size, (size_t)WS_END); grid = -1; return; }
        int dev = 0, cus = 0, per_cu = 0;
        hipGetDevice(&dev);
        hipDeviceGetAttribute(&cus, hipDeviceAttributeMultiprocessorCount, dev);
        hipFuncSetAttribute((const void*)fwd_kernel, hipFuncAttributeMaxDynamicSharedMemorySize, LDS_BYTES);
        hipOccupancyMaxActiveBlocksPerMultiprocessor(&per_cu, (const void*)fwd_kernel, 512, LDS_BYTES);
        if (per_cu < 1) { fprintf(stderr, "kernel_launch: occupancy query says %d blocks/CU\n", per_cu); per_cu = 1; }
        (void)hipGetLastError();
        grid = cus;
        if (grid != 256) { fprintf(stderr, "kernel_launch: this kernel is laid out for a 256-CU device (got %d CUs); nothing launched\n", cus); grid = -1; return; }
    }
    if (grid < 0) return;
    hipMemsetAsync((char*)d_ws + WS_CTL, 0, CTL_BYTES, stream);
    Args a{};
    for (int i = 0; i < 22; ++i) a.in[i] = (const float*)d_in[i];
    a.out = (float*)d_out; a.ws = (unsigned char*)d_ws;
    void* args[] = {&a};
    hipError_t e = hipLaunchCooperativeKernel((const void*)fwd_kernel, dim3(grid), dim3(512), args, LDS_BYTES, stream);
    if (e != hipSuccess) fprintf(stderr, "cooperative launch failed: %s (grid %d)\n", hipGetErrorString(e), grid);
}
```

```cpp
#include <hip/hip_runtime.h>
#include <hip/hip_cooperative_groups.h>
#include <cstdio>
#include <cstdint>
namespace cg = cooperative_groups;

#define LAS __attribute__((address_space(3)))
typedef unsigned short bf16_t;
typedef short bf16x8 __attribute__((ext_vector_type(8)));
typedef float f32x4 __attribute__((ext_vector_type(4)));
typedef unsigned u32x4 __attribute__((ext_vector_type(4)));
typedef unsigned u32x2 __attribute__((ext_vector_type(2)));

constexpr int D = 1024, NB = 32, T = 2048, CL = 256, DFF = 2816;
constexpr int NLAT = NB * T, NCTX = NB * CL, NTOK = NLAT + NCTX;
constexpr int NG = 2, GB = NB / NG, GLAT = GB * T, GCTX = GB * CL, GTOK = GLAT + GCTX;
constexpr int PW = 6656;
constexpr int INW = 6416;
constexpr int C_POOL = 0, C_QM = 512, C_KM = 1024, C_VM = 1536, C_OM = 2048, C_QA = 2560, C_KA = 3072, C_VA = 3200, C_GATE = 3328, C_IG = 6400, C_FG = 6408;
constexpr int PW2 = 4352, P_POOL = 0, P_OM = 512, P_GATE = 1024;
constexpr float LN_EPS = 1e-5f;
constexpr float DN_ALPHA = 1.41421356237309515f;
constexpr int LDS_BYTES = 155648;

constexpr size_t al256(size_t x) { return (x + 255) & ~(size_t)255; }
constexpr size_t WS_CTL = 0, CTL_BYTES = 32768;
constexpr size_t WS_MOD = 32768;
constexpr size_t WS_ROPE = al256(WS_MOD + (size_t)2 * 33 * 6144 * 4);
constexpr size_t WS_STATS = al256(WS_ROPE + (size_t)2048 * 32 * 8);
constexpr size_t WS_W = al256(WS_STATS + (size_t)NTOK * 8);
constexpr size_t W_IN = 0, W_BR = W_IN + (size_t)PW * D * 2, W_OUT = W_BR + (size_t)3 * D * 512 * 2, W_GU = W_OUT + (size_t)D * D * 2,
                 W_DN = W_GU + (size_t)2 * DFF * D * 2, W_LAYER = W_DN + (size_t)D * DFF * 2;
constexpr size_t WS_CTXX = al256(WS_W + 2 * W_LAYER);
constexpr size_t WS_H = al256(WS_CTXX + (size_t)NCTX * D * 4);
constexpr size_t WS_P = al256(WS_H + (size_t)NTOK * D * 2);
constexpr size_t WS_MQ = al256(WS_P + (size_t)GTOK * PW2 * 2);
constexpr size_t WS_AQ = al256(WS_MQ + (size_t)12 * GTOK * 128 * 2);
constexpr size_t WS_AK = al256(WS_AQ + (size_t)8 * GTOK * 64 * 2);
constexpr size_t WS_AV = al256(WS_AK + (size_t)2 * GTOK * 64 * 2);
constexpr size_t WS_IGF = al256(WS_AV + (size_t)2 * GTOK * 64 * 2);
constexpr size_t WS_U = al256(WS_IGF + (size_t)16 * GTOK * 2);
constexpr size_t WS_Y = al256(WS_U + (size_t)GTOK * 1536 * 2);
constexpr size_t WS_END = al256(WS_Y + (size_t)GTOK * D * 2);
static_assert(WS_P + (size_t)NTOK * DFF * 2 <= WS_U, "ACT overlays P2 and the mixer-input buffers");
static_assert(WS_END <= ((size_t)1 << 30), "workspace map must fit 1 GiB");

__device__ __forceinline__ unsigned f2bf(float f) { unsigned u = __builtin_bit_cast(unsigned, f); return (u + 0x7fffu + ((u >> 16) & 1u)) >> 16; }
__device__ __forceinline__ unsigned pk2(float lo, float hi) { unsigned r; asm("v_cvt_pk_bf16_f32 %0, %1, %2" : "=v"(r) : "v"(lo), "v"(hi)); return r; }
__device__ __forceinline__ float bflo(unsigned w) { return __builtin_bit_cast(float, w << 16); }
__device__ __forceinline__ float bfhi(unsigned w) { return __builtin_bit_cast(float, w & 0xffff0000u); }
__device__ __forceinline__ float bf2f(bf16_t h) { return __builtin_bit_cast(float, (unsigned)h << 16); }
__device__ __forceinline__ int opq(int x) { asm volatile("" : "+v"(x)); return x; }
__device__ __forceinline__ int lane_id() { int r; asm volatile("v_mbcnt_lo_u32_b32 %0, -1, 0\n\tv_mbcnt_hi_u32_b32 %0, -1, %0" : "=v"(r)); return r; }
__device__ __forceinline__ float shx(float v, int o, int lane) { return __builtin_bit_cast(float, __builtin_amdgcn_ds_bpermute((lane ^ o) << 2, __builtin_bit_cast(int, v))); }
__device__ __forceinline__ float shup(float v, int o, int lane) { return __builtin_bit_cast(float, __builtin_amdgcn_ds_bpermute((lane - o) << 2, __builtin_bit_cast(int, v))); }
__device__ __forceinline__ float shidx(float v, int src) { return __builtin_bit_cast(float, __builtin_amdgcn_ds_bpermute(src << 2, __builtin_bit_cast(int, v))); }
__device__ __forceinline__ float wave_sum(float v, int lane) {
#pragma unroll
    for (int o = 1; o < 64; o <<= 1) v += shx(v, o, lane);
    return v;
}
__device__ __forceinline__ int opqs(int x) { asm volatile("" : "+s"(x)); return x; }
typedef float f32x2 __attribute__((ext_vector_type(2)));
__device__ __forceinline__ float max3f(float a, float b, float c) { float r; asm("v_max3_f32 %0, %1, %2, %3" : "=v"(r) : "v"(a), "v"(b), "v"(c)); return r; }
__device__ __forceinline__ float max2f(float a, float b) { float r; asm("v_max_f32_e32 %0, %1, %2" : "=v"(r) : "v"(a), "v"(b)); return r; }
__device__ __forceinline__ float sigmoidf_(float x) { return __builtin_amdgcn_rcpf(1.f + __expf(-x)); }

namespace pg8 {
constexpr int BM = 256, BK = 64, HALF = 128, HTB = HALF * BK * 2, STAGE_BYTES = 8 * HTB, NXCD = 8, WGM = 8;
__device__ __forceinline__ int lds_byte(int r, int c) { const int st = (r >> 4) * 2 + (c >> 5), rr = r & 15, cc = c & 31, ob = rr * 64 + cc * 2; return st * 1024 + (ob ^ (((ob >> 9) & 1) << 5)); }
__device__ __forceinline__ void stage_rc(int b, int& R, int& C) { const int st = b / 1024, sb = b % 1024, swz = sb ^ (((sb >> 9) & 1) << 5); R = (st >> 1) * 16 + swz / 64; C = (st & 1) * 32 + (swz % 64) / 2; }
__device__ __forceinline__ int perm32(int rho) { const int n = rho >> 4, i = rho & 15; return 8 * (i >> 2) + 4 * n + (i & 3); }

struct Unit { int pa, pb, po, br; };

struct Seg { const char* A; const char* Bt; size_t a_tile, b_tile; int nM, nN, nwg, lat_n, a_lat, a_ctx, o_lat, o_ctx, pbmap; };
struct Sched {
    Seg s0, s1; int nseg, G, c;
    __device__ __forceinline__ bool next(int i, Unit& u) const {
        long L = (long)i * G + c; int k = 0;
        if (L >= s0.nwg) { if (nseg < 2) return false; L -= s0.nwg; k = 1; if (L >= s1.nwg) return false; }
        const int nwg = k ? s1.nwg : s0.nwg, nM = k ? s1.nM : s0.nM, nN = k ? s1.nN : s0.nN, lat_n = k ? s1.lat_n : s0.lat_n;
        const int a_lat = k ? s1.a_lat : s0.a_lat, a_ctx = k ? s1.a_ctx : s0.a_ctx, o_lat = k ? s1.o_lat : s0.o_lat, o_ctx = k ? s1.o_ctx : s0.o_ctx, pbmap = k ? s1.pbmap : s0.pbmap;
        u.br = k;
        int wgid = (int)L; { const int q = nwg / NXCD, r = nwg % NXCD, xcd = wgid % NXCD, off = wgid / NXCD; wgid = (xcd < r ? xcd * (q + 1) : r * (q + 1) + (xcd - r) * q) + off; }
        const int nig = WGM * nN, gid = wgid / nig, fm = gid * WGM, gsz = (nM - fm) < WGM ? (nM - fm) : WGM;
        const int pm = fm + ((wgid % nig) % gsz); const int pn = (wgid % nig) / gsz;
        u.pb = pbmap ? (pn < 6 ? pn + 2 : (pn == 6 ? 12 : 25)) : pn;
        if (pm < lat_n) { u.pa = a_lat + pm; u.po = o_lat + pm; } else { u.pa = a_ctx + pm - lat_n; u.po = o_ctx + pm - lat_n; }
        return true;
    }
    __device__ __forceinline__ const char* aptr(const Unit& u) const { return (u.br ? s1.A : s0.A) + (size_t)u.pa * (u.br ? s1.a_tile : s0.a_tile); }
    __device__ __forceinline__ const char* bptr(const Unit& u) const { return (u.br ? s1.Bt : s0.Bt) + (size_t)u.pb * (u.br ? s1.b_tile : s0.b_tile); }
};

template <class Epi, int K, int lda, int ldb>
__device__ __forceinline__ void gemm_phase(LAS unsigned char* lds, const Sched& S, const Epi& E, const int wv) {
    const int tid = opq(wv * 64 + lane_id()), wid = __builtin_amdgcn_readfirstlane(tid >> 6), lane = tid & 63, wr = wid >> 2, wc = wid & 3, fr = lane & 15, fq = lane >> 4;
    const int nt = K / BK;
    unsigned voffA[2], voffB[2];
#pragma unroll
    for (int i = 0; i < 2; ++i) { int R, C; stage_rc(tid * 16 + i * 8192, R, C); const int Rb = (R & ~31) + perm32(R & 31);
        voffA[i] = (unsigned)(R * lda + C) * 2u; voffB[i] = (unsigned)(Rb * ldb + C) * 2u; }
    const size_t kstep = (size_t)(BK * 2);
    const size_t hstepA = (size_t)HALF * lda * 2, hstepB = (size_t)HALF * ldb * 2;
    const unsigned ldsw = (unsigned)wid * 1024u;
    const int aoff = lds_byte(wr * 64 + fr, fq * 8), boff = lds_byte(wc * 32 + fr, fq * 8);
#define PG8_SA(b, h) (((b) * 2 + (h)) * HTB)
#define PG8_SB(b, h) ((4 + (b) * 2 + (h)) * HTB)
#define PG8_STAGE(bufoff, gbase, voff) do { _Pragma("unroll") for (int _i = 0; _i < 2; ++_i) \
        __builtin_amdgcn_global_load_lds((const unsigned*)((const char*)(gbase) + (voff)[_i]), (LAS unsigned*)(lds + (bufoff) + ldsw + _i * 8192), 16, 0, 0); } while (0)
#define PG8_LDA(dst, b, h) do { _Pragma("unroll") for (int m = 0; m < 4; ++m) _Pragma("unroll") for (int k = 0; k < 2; ++k) dst[m][k] = *(const LAS bf16x8*)(lds + PG8_SA(b, h) + aoff + m * 2048 + k * 1024); } while (0)
#define PG8_LDB(dst, b, h) do { _Pragma("unroll") for (int n = 0; n < 2; ++n) _Pragma("unroll") for (int k = 0; k < 2; ++k) dst[n][k] = *(const LAS bf16x8*)(lds + PG8_SB(b, h) + boff + n * 2048 + k * 1024); } while (0)
#define PG8_MMA(ai, bj, At, Bt) do { __builtin_amdgcn_s_setprio(1); _Pragma("unroll") for (int m = 0; m < 4; ++m) _Pragma("unroll") for (int n = 0; n < 2; ++n) _Pragma("unroll") for (int k = 0; k < 2; ++k) \
        acc[ai][bj][m][n] = __builtin_amdgcn_mfma_f32_16x16x32_bf16(Bt[n][k], At[m][k], acc[ai][bj][m][n], 0, 0, 0); __builtin_amdgcn_s_setprio(0); } while (0)
#define PG8_WAIT_V(n) asm volatile("s_waitcnt vmcnt(" #n ")" ::: "memory")
#define PG8_WAIT_L(n) asm volatile("s_waitcnt lgkmcnt(" #n ")" ::: "memory")
#define PG8_BAR __builtin_amdgcn_s_barrier()
#define PG8_SCHED __builtin_amdgcn_sched_barrier(0)
    Unit cur, nxt; int ui = 0;
    if (!S.next(0, cur)) return;
    f32x4 acc[2][2][4][2];
#pragma unroll
    for (int a = 0; a < 2; ++a)
#pragma unroll
        for (int b = 0; b < 2; ++b)
#pragma unroll
            for (int m = 0; m < 4; ++m)
#pragma unroll
                for (int n = 0; n < 2; ++n) acc[a][b][m][n] = (f32x4){0.f, 0.f, 0.f, 0.f};
    bf16x8 At[4][2], B0[2][2], B1[2][2];
    const char* cA = S.aptr(cur); const char* cB = S.bptr(cur);
    PG8_STAGE(PG8_SB(0, 0), cB, voffB); PG8_STAGE(PG8_SB(0, 1), cB + hstepB, voffB); PG8_STAGE(PG8_SA(0, 0), cA, voffA); PG8_STAGE(PG8_SA(0, 1), cA + hstepA, voffA);
    if (wr == 1) PG8_BAR;
    PG8_WAIT_V(2); PG8_BAR;
    PG8_STAGE(PG8_SB(1, 0), cB + kstep, voffB); PG8_STAGE(PG8_SA(1, 0), cA + kstep, voffA); PG8_STAGE(PG8_SB(1, 1), cB + hstepB + kstep, voffB);
    PG8_WAIT_V(6); PG8_BAR;
    for (;;) {
        const bool has_next = S.next(ui + 1, nxt);
        const char* nA = has_next ? S.aptr(nxt) : cA; const char* nB = has_next ? S.bptr(nxt) : cB;
        for (int t = 0; t < nt; t += 2) {
            if constexpr (Epi::HOOK) { if (t == 8 || t == 16) E.hook(acc, cur, t >> 3, wr, wc, fr, fq); }
            const bool last = (t == nt - 2);
            const char* a1 = cA + (size_t)(t + 1) * kstep;
            const char* a2 = last ? nA : cA + (size_t)(t + 2) * kstep; const char* b2 = last ? nB : cB + (size_t)(t + 2) * kstep;
            const char* a3 = a2 + kstep; const char* b3 = b2 + kstep;
            PG8_LDB(B0, 0, 0); PG8_LDB(B1, 0, 1); PG8_SCHED; PG8_LDA(At, 0, 0); PG8_STAGE(PG8_SA(1, 1), a1 + hstepA, voffA);
            PG8_WAIT_V(8); PG8_WAIT_L(0); PG8_BAR; PG8_MMA(0, 0, At, B0); PG8_MMA(0, 1, At, B1); PG8_BAR; PG8_SCHED;
            PG8_LDA(At, 0, 1); PG8_STAGE(PG8_SB(0, 0), b2, voffB); PG8_STAGE(PG8_SB(0, 1), b2 + hstepB, voffB); PG8_STAGE(PG8_SA(0, 0), a2, voffA);
            PG8_WAIT_V(8); PG8_WAIT_L(0); PG8_BAR; PG8_MMA(1, 0, At, B0); PG8_MMA(1, 1, At, B1); PG8_BAR; PG8_SCHED;
            PG8_LDB(B0, 1, 0); PG8_LDB(B1, 1, 1); PG8_SCHED; PG8_LDA(At, 1, 0); PG8_STAGE(PG8_SA(0, 1), a2 + hstepA, voffA);
            PG8_WAIT_V(8); PG8_WAIT_L(0); PG8_BAR; PG8_MMA(0, 0, At, B0); PG8_MMA(0, 1, At, B1); PG8_BAR; PG8_SCHED;
            PG8_LDA(At, 1, 1); PG8_STAGE(PG8_SB(1, 0), b3, voffB); PG8_STAGE(PG8_SB(1, 1), b3 + hstepB, voffB); PG8_STAGE(PG8_SA(1, 0), a3, voffA);
            PG8_WAIT_V(8); PG8_WAIT_L(0); PG8_BAR; PG8_MMA(1, 0, At, B0); PG8_MMA(1, 1, At, B1); PG8_BAR; PG8_SCHED;
        }
        if (wr == 0) PG8_BAR;
        E(acc, cur, wr, wc, fr, fq);
        if (!has_next) break;
#pragma unroll
        for (int a = 0; a < 2; ++a)
#pragma unroll
            for (int b = 0; b < 2; ++b)
#pragma unroll
                for (int m = 0; m < 4; ++m)
#pragma unroll
                    for (int n = 0; n < 2; ++n) acc[a][b][m][n] = (f32x4){0.f, 0.f, 0.f, 0.f};
        cur = nxt; cA = nA; cB = nB; ++ui;
        if (wr == 1) PG8_BAR;
    }
    PG8_WAIT_V(0);
    PG8_BAR;
#undef PG8_SA
#undef PG8_SB
#undef PG8_STAGE
#undef PG8_LDA
#undef PG8_LDB
#undef PG8_MMA
#undef PG8_WAIT_V
#undef PG8_WAIT_L
#undef PG8_BAR
#undef PG8_SCHED
}

struct EpiP {
    static constexpr bool HOOK = false;
    bf16_t* P2; bf16_t* MQ; bf16_t* AQ; bf16_t* AK; bf16_t* AV; bf16_t* IGF;
    __device__ __forceinline__ void operator()(const f32x4 (&acc)[2][2][4][2], const Unit& u, int wr, int wc, int fr_, int fq_) const {
        const int fr = opq(fr_), fq = opq(fq_);
        const int pb = u.pb, row0 = u.po * BM + wr * 64 + fr, cw = wc * 32 + 8 * fq;
        if (pb == 25) {
            if (wc == 0 && fq < 2) {
#pragma unroll
                for (int ai = 0; ai < 2; ++ai)
#pragma unroll
                    for (int m = 0; m < 4; ++m) { bf16_t* gp = IGF + (size_t)(8 * fq) * GTOK + row0 + ai * HALF + m * 16;
#pragma unroll
                        for (int n = 0; n < 2; ++n)
#pragma unroll
                            for (int j = 0; j < 4; ++j) gp[(size_t)(4 * n + j) * GTOK] = (bf16_t)f2bf(acc[ai][0][m][n][j]); }
            }
            return;
        }
        const bool isg = pb >= 13;
        bf16_t* db[2]; int rs;
#pragma unroll
        for (int bj = 0; bj < 2; ++bj) {
            if (pb < 2)       { db[bj] = P2 + P_POOL + pb * 256 + bj * HALF + cw; rs = PW2; }
            else if (pb < 8)  { db[bj] = MQ + (size_t)(((pb - 2) >> 1) * 4 + ((pb - 2) & 1) * 2 + bj) * GTOK * 128 + cw; rs = 128; }
            else if (pb < 10) { db[bj] = P2 + P_OM + (pb - 8) * 256 + bj * HALF + cw; rs = PW2; }
            else if (pb < 12) { db[bj] = AQ + (size_t)((pb - 10) * 4 + bj * 2 + (wc >> 1)) * GTOK * 64 + (wc & 1) * 32 + 8 * fq; rs = 64; }
            else if (pb < 13) { db[bj] = (bj == 0 ? AK : AV) + (size_t)(wc >> 1) * GTOK * 64 + (wc & 1) * 32 + 8 * fq; rs = 64; }
            else              { db[bj] = P2 + P_GATE + (pb - 13) * 256 + bj * HALF + cw; rs = PW2; }
        }
#pragma unroll
        for (int ai = 0; ai < 2; ++ai)
#pragma unroll
            for (int m = 0; m < 4; ++m) { const size_t ro = (size_t)(row0 + ai * HALF + m * 16) * rs;
#pragma unroll
                for (int bj = 0; bj < 2; ++bj) { f32x4 v0 = acc[ai][bj][m][0], v1 = acc[ai][bj][m][1];
                    if (isg) {
#pragma unroll
                        for (int j = 0; j < 4; ++j) { v0[j] = __builtin_amdgcn_exp2f(__builtin_amdgcn_fmed3f(v0[j], -30.f, 30.f) * -1.4426950408889634f);
                                                      v1[j] = __builtin_amdgcn_exp2f(__builtin_amdgcn_fmed3f(v1[j], -30.f, 30.f) * -1.4426950408889634f); }
                        v0 = v0 + 1.f; v1 = v1 + 1.f; }
                    u32x4 w; w.x = pk2(v0[0], v0[1]); w.y = pk2(v0[2], v0[3]); w.z = pk2(v1[0], v1[1]); w.w = pk2(v1[2], v1[3]);
                    *(u32x4*)(db[bj] + ro) = w; } }
    }
};
struct EpiMerge {
    static constexpr bool HOOK = true;
    const bf16_t* P; bf16_t* Y;
    __device__ __forceinline__ void hook(f32x4 (&acc)[2][2][4][2], const Unit& u, int i, int wr, int wc, int fr_, int fq_) const {
        const int fr = opq(fr_), fq = opq(fq_);
        const int row0 = u.po * BM + wr * 64 + fr, col0 = u.pb * BM + wc * 32 + 8 * fq;
        const bf16_t* gbase = P + (size_t)row0 * PW2 + P_GATE + (i - 1) * 1024 + col0;
        u32x4 ga[2][2][2], gb[2][2][2];
#define HK_LOAD(buf, b) do { _Pragma("unroll") for (int mm = 0; mm < 2; ++mm) { const bf16_t* gp = gbase + (size_t)(((b) >> 1) * HALF + (2 * ((b) & 1) + mm) * 16) * PW2; \
            _Pragma("unroll") for (int bj = 0; bj < 2; ++bj) { ga[buf][mm][bj] = *(const u32x4*)(gp + bj * HALF); gb[buf][mm][bj] = *(const u32x4*)(gp + 1024 + bj * HALF); } } } while (0)
#define HK_APPLY(buf, b) do { _Pragma("unroll") for (int mm = 0; mm < 2; ++mm) _Pragma("unroll") for (int bj = 0; bj < 2; ++bj) _Pragma("unroll") for (int j = 0; j < 4; ++j) { \
            const float r0 = bflo(gb[buf][mm][bj][j]) * __builtin_amdgcn_rcpf(bflo(ga[buf][mm][bj][j])); \
            const float r1 = bfhi(gb[buf][mm][bj][j]) * __builtin_amdgcn_rcpf(bfhi(ga[buf][mm][bj][j])); \
            acc[(b) >> 1][bj][2 * ((b) & 1) + mm][j >> 1][(j & 1) * 2] *= r0; acc[(b) >> 1][bj][2 * ((b) & 1) + mm][j >> 1][(j & 1) * 2 + 1] *= r1; } } while (0)
        HK_LOAD(0, 0); __builtin_amdgcn_sched_barrier(0);
        HK_LOAD(1, 1); HK_APPLY(0, 0); __builtin_amdgcn_sched_barrier(0);
        HK_LOAD(0, 2); HK_APPLY(1, 1); __builtin_amdgcn_sched_barrier(0);
        HK_LOAD(1, 3); HK_APPLY(0, 2); __builtin_amdgcn_sched_barrier(0);
        HK_APPLY(1, 3); __builtin_amdgcn_sched_barrier(0);
#undef HK_LOAD
#undef HK_APPLY
    }
    __device__ __forceinline__ void operator()(const f32x4 (&acc)[2][2][4][2], const Unit& u, int wr, int wc, int fr_, int fq_) const {
        const int fr = opq(fr_), fq = opq(fq_);
        const int row0 = u.po * BM + wr * 64 + fr, col0 = u.pb * BM + wc * 32 + 8 * fq;
#pragma unroll
        for (int ai = 0; ai < 2; ++ai) {
            u32x4 g[4][2];
#pragma unroll
            for (int m = 0; m < 4; ++m)
#pragma unroll
                for (int bj = 0; bj < 2; ++bj) g[m][bj] = *(const u32x4*)(P + (size_t)(row0 + ai * HALF + m * 16) * PW2 + P_GATE + 2048 + col0 + bj * HALF);
#pragma unroll
            for (int m = 0; m < 4; ++m)
#pragma unroll
                for (int bj = 0; bj < 2; ++bj) {
                    const f32x4 v0 = acc[ai][bj][m][0], v1 = acc[ai][bj][m][1]; const u32x4 e = g[m][bj];
                    u32x4 w;
                    w.x = pk2(v0[0] * __builtin_amdgcn_rcpf(bflo(e.x)), v0[1] * __builtin_amdgcn_rcpf(bfhi(e.x))); w.y = pk2(v0[2] * __builtin_amdgcn_rcpf(bflo(e.y)), v0[3] * __builtin_amdgcn_rcpf(bfhi(e.y)));
                    w.z = pk2(v1[0] * __builtin_amdgcn_rcpf(bflo(e.z)), v1[1] * __builtin_amdgcn_rcpf(bfhi(e.z))); w.w = pk2(v1[2] * __builtin_amdgcn_rcpf(bflo(e.w)), v1[3] * __builtin_amdgcn_rcpf(bfhi(e.w)));
                    *(u32x4*)(Y + (size_t)(row0 + ai * HALF + m * 16) * D + col0 + bj * HALF) = w; }
        }
    }
};
struct EpiRes {
    static constexpr bool HOOK = false;
    const float* xs_lat; const float* xs_ctx; float* xd_lat; float* xd_ctx; const float* gmod;
    const float* stats; const float* lng; const float* lnb;
    __device__ __forceinline__ void operator()(const f32x4 (&acc)[2][2][4][2], const Unit& u, int wr, int wc, int fr_, int fq_) const {
        const int fr = opq(fr_), fq = opq(fq_);
        const bool lat = u.po < 256; const int b = lat ? (u.po >> 3) : 32;
        const float* src = lat ? xs_lat + (size_t)u.po * 256 * D : xs_ctx + (size_t)(u.po - 256) * 256 * D;
        float* dst = lat ? xd_lat + (size_t)u.po * 256 * D : xd_ctx + (size_t)(u.po - 256) * 256 * D;
        const int col0 = u.pb * BM + wc * 32 + 8 * fq;
        const float* gv = gmod + (size_t)b * 6144 + col0;
        const float2* st = (const float2*)stats + (size_t)u.po * 256 + wr * 64 + fr;
#pragma unroll
        for (int bj = 0; bj < 2; ++bj) {
            f32x4 g[2], lg[2], lb[2];
#pragma unroll
            for (int n = 0; n < 2; ++n) { g[n] = *(const f32x4*)(gv + bj * HALF + 4 * n);
                if (stats) { lg[n] = *(const f32x4*)(lng + col0 + bj * HALF + 4 * n) * DN_ALPHA; lb[n] = *(const f32x4*)(lnb + col0 + bj * HALF + 4 * n) * DN_ALPHA; }
                else { lg[n] = (f32x4){DN_ALPHA, DN_ALPHA, DN_ALPHA, DN_ALPHA}; lb[n] = (f32x4){0.f, 0.f, 0.f, 0.f}; } }
#pragma unroll
            for (int ai = 0; ai < 2; ++ai) {
                f32x4 xv[4][2]; float mu[4], rs[4];
#pragma unroll
                for (int m = 0; m < 4; ++m) { const int rl = ai * HALF + m * 16; const size_t ro = (size_t)(wr * 64 + fr + rl) * D + col0 + bj * HALF;
                    if (stats) { const float2 sv = st[rl]; mu[m] = sv.x; rs[m] = sv.y; } else { mu[m] = 0.f; rs[m] = 1.f; }
#pragma unroll
                    for (int n = 0; n < 2; ++n) xv[m][n] = *(const f32x4*)(src + ro + 4 * n); }
                __builtin_amdgcn_sched_barrier(0);
#pragma unroll
                for (int m = 0; m < 4; ++m) { const int rl = ai * HALF + m * 16; const size_t ro = (size_t)(wr * 64 + fr + rl) * D + col0 + bj * HALF;
#pragma unroll
                    for (int n = 0; n < 2; ++n) *(f32x4*)(dst + ro + 4 * n) = (xv[m][n] - mu[m]) * rs[m] * lg[n] + lb[n] + g[n] * acc[ai][bj][m][n]; }
                __builtin_amdgcn_sched_barrier(0);
            }
        }
    }
};
struct EpiUp {
    static constexpr bool HOOK = false;
    bf16_t* O;
    __device__ __forceinline__ void operator()(const f32x4 (&acc)[2][2][4][2], const Unit& u, int wr, int wc, int fr_, int fq_) const {
        const int fr = opq(fr_), fq = opq(fq_);
        const int row0 = u.po * BM + wr * 64 + fr, col0 = u.pb * HALF + wc * 32 + 8 * fq;
#pragma unroll
        for (int ai = 0; ai < 2; ++ai)
#pragma unroll
            for (int m = 0; m < 4; ++m) {
                float t[8];
#pragma unroll
                for (int n = 0; n < 2; ++n)
#pragma unroll
                    for (int h = 0; h < 2; ++h) {
                        const f32x2 gg = (f32x2){acc[ai][0][m][n][2 * h], acc[ai][0][m][n][2 * h + 1]}, uu = (f32x2){acc[ai][1][m][n][2 * h], acc[ai][1][m][n][2 * h + 1]};
                        const f32x2 ea = gg * (f32x2){-1.4426950408889634f, -1.4426950408889634f};
                        f32x2 e; e.x = __builtin_amdgcn_exp2f(ea.x); e.y = __builtin_amdgcn_exp2f(ea.y);
                        e = e + (f32x2){1.f, 1.f};
                        f32x2 r; r.x = __builtin_amdgcn_rcpf(e.x); r.y = __builtin_amdgcn_rcpf(e.y);
                        const f32x2 o = (gg * uu) * r;
                        t[4 * n + 2 * h] = o.x; t[4 * n + 2 * h + 1] = o.y; }
                u32x4 w; w.x = pk2(t[0], t[1]); w.y = pk2(t[2], t[3]); w.z = pk2(t[4], t[5]); w.w = pk2(t[6], t[7]);
                *(u32x4*)(O + (size_t)(row0 + ai * HALF + m * 16) * DFF + col0) = w; }
    }
};
struct EpiDual {
    static constexpr bool HOOK = false;
    EpiRes r; EpiP p;
    __device__ __forceinline__ void operator()(const f32x4 (&acc)[2][2][4][2], const Unit& u, int wr, int wc, int fr, int fq) const {
        if (u.br == 0) r(acc, u, wr, wc, fr, fq); else p(acc, u, wr, wc, fr, fq);
    }
};
}

struct Args { const float* in[22]; float* out; unsigned char* ws; };
enum { I_X = 0, I_C, I_CTX, I_CCTX, I_WMOD, I_BMOD, I_WIN, I_POOLW, I_POOLS, I_MBI, I_MBF, I_MNORM, I_SINK, I_WBR, I_WOUT, I_LN1G, I_LN1B, I_LN2G, I_LN2B, I_WG, I_WU, I_WD };

__device__ __forceinline__ void transpose_item(const float* W, int K, int N, bf16_t* WT, int ldk, int mode, LAS float* scr, int item, int lane) {
    const int nblk = (N + 31) / 32, kb = item / nblk, nb = item % nblk, k0 = 64 * kb, n0 = 32 * nb;
    const int nn = n0 + (lane & 31);
    float tv[32];
#pragma unroll
    for (int i = 0; i < 32; ++i) { const int kk = 2 * i + (lane >> 5); tv[i] = nn < N ? W[(size_t)(k0 + kk) * N + nn] : 0.f; }
#pragma unroll
    for (int i = 0; i < 32; ++i) { const int kk = 2 * i + (lane >> 5); scr[kk * 33 + (lane & 31)] = tv[i]; }
    asm volatile("s_waitcnt lgkmcnt(0)" ::: "memory");
    const int c = lane & 7;
#pragma unroll
    for (int j = 0; j < 4; ++j) { const int n = (lane >> 3) + 8 * j; const LAS float* s = scr + (8 * c) * 33 + n;
        u32x4 o; o.x = pk2(s[0 * 33], s[1 * 33]); o.y = pk2(s[2 * 33], s[3 * 33]); o.z = pk2(s[4 * 33], s[5 * 33]); o.w = pk2(s[6 * 33], s[7 * 33]);
        const int ng = n0 + n;
        if (ng < N) { const int row = mode == 0 ? ng : (mode == 3 ? (ng < 2560 ? ng : (ng < 2576 ? ng + 3840 : ng - 16)) : ((ng >> 7) * 256 + (ng & 127) + (mode == 2 ? 128 : 0)));
            *(u32x4*)(WT + (size_t)row * ldk + k0 + 8 * c) = o; } }
    asm volatile("s_waitcnt lgkmcnt(0)" ::: "memory");
}

__device__ __forceinline__ void wpb_item(const __attribute__((address_space(4))) Args* a, LAS unsigned char* lds, int it, int tid) {
    unsigned char* ws = a->ws;
    const int l = it >> 5, g = (it >> 3) & 3, n0 = (it & 7) * 128;
        LAS float* pwt = (LAS float*)lds;
        LAS float* wbs = pwt + 128 * 128;
        const float* pw = a->in[I_POOLW] + ((size_t)l * 4 + g) * 128 * 128; const float* ps = a->in[I_POOLS] + l * 512 + g * 128;
        const float* wb0 = a->in[I_WBR] + (size_t)l * 3 * 512 * D + (size_t)(g * 128) * D + n0;
#pragma unroll 4
        for (int e = tid; e < 128 * 128; e += 512) { const int c = e >> 7, d = e & 127; pwt[d * 128 + c] = pw[e] * ps[d]; wbs[e] = wb0[(size_t)(e >> 7) * D + (e & 127)]; }
        __syncthreads();
        const int n = tid & 127, cq = tid >> 7;
        bf16_t* dst = (bf16_t*)(ws + WS_W + l * W_LAYER + W_BR) + (size_t)(n0 + n) * 1536 + g * 128 + cq * 32;
#pragma unroll 1
        for (int cg = 0; cg < 8; ++cg) {
            f32x4 sacc = (f32x4){0.f, 0.f, 0.f, 0.f};
#pragma unroll 8
            for (int d = 0; d < 128; ++d) { const f32x4 pv = *(const LAS f32x4*)(pwt + d * 128 + cq * 32 + cg * 4); sacc += pv * wbs[d * 128 + n]; }
            u32x2 o; o.x = pk2(sacc[0], sacc[1]); o.y = pk2(sacc[2], sacc[3]);
            *(u32x2*)(dst + cg * 4) = o;
        }
        __syncthreads();
}
constexpr int TI_IN = 16 * 201, TI_B = 8 * 32, TI_O = 16 * 32, TI_G = 16 * 88, TI_D = 44 * 32, T_PER_L = TI_IN + 2 * TI_B + TI_O + 2 * TI_G + TI_D;
__device__ __forceinline__ void transpose_dispatch(const __attribute__((address_space(4))) Args* a, LAS float* scr, int it, int lane) {
    unsigned char* ws = a->ws;
    constexpr int PER_L = T_PER_L, I_IN = TI_IN, I_B = TI_B, I_O = TI_O, I_G = TI_G;
    do {
            const int l = it / PER_L; int r = it % PER_L;
            unsigned char* wl = ws + WS_W + l * W_LAYER;
            if (r < I_IN) { transpose_item(a->in[I_WIN] + (size_t)l * D * INW, D, INW, (bf16_t*)(wl + W_IN), D, 3, scr, r, lane); break; } r -= I_IN;
            if (r < I_B) { transpose_item(a->in[I_WBR] + ((size_t)l * 3 + 1) * 512 * D, 512, D, (bf16_t*)(wl + W_BR) + 512, 1536, 0, scr, r, lane); break; } r -= I_B;
            if (r < I_B) { transpose_item(a->in[I_WBR] + ((size_t)l * 3 + 2) * 512 * D, 512, D, (bf16_t*)(wl + W_BR) + 1024, 1536, 0, scr, r, lane); break; } r -= I_B;
            if (r < I_O) { transpose_item(a->in[I_WOUT] + (size_t)l * D * D, D, D, (bf16_t*)(wl + W_OUT), D, 0, scr, r, lane); break; } r -= I_O;
            if (r < I_G) { transpose_item(a->in[I_WG] + (size_t)l * D * DFF, D, DFF, (bf16_t*)(wl + W_GU), D, 1, scr, r, lane); break; } r -= I_G;
            if (r < I_G) { transpose_item(a->in[I_WU] + (size_t)l * D * DFF, D, DFF, (bf16_t*)(wl + W_GU), D, 2, scr, r, lane); break; } r -= I_G;
            transpose_item(a->in[I_WD] + (size_t)l * DFF * D, DFF, D, (bf16_t*)(wl + W_DN), DFF, 0, scr, r, lane);
    } while (0);
}
__device__ __forceinline__ void prologue(const __attribute__((address_space(4))) Args* a, LAS unsigned char* lds, const int wv) {
    const int tid = opq(wv * 64 + lane_id()), lane = tid & 63, wave = __builtin_amdgcn_readfirstlane(tid >> 6);
    unsigned char* ws = a->ws;
    if (blockIdx.x < 192) {
        const int l = blockIdx.x / 96, n = (blockIdx.x % 96) * 64 + (tid & 63), sl = tid >> 6;
        LAS float* s = (LAS float*)lds;
        for (int e = tid; e < 33 * 1024; e += 512) { const float v = e < 32 * 1024 ? a->in[I_C][e] : a->in[I_CCTX][e - 32 * 1024]; s[e] = v * sigmoidf_(v); }
        __syncthreads();
        float acc[33];
#pragma unroll
        for (int b = 0; b < 33; ++b) acc[b] = 0.f;
        const float* wm = a->in[I_WMOD] + (size_t)l * D * 6144 + (size_t)(sl * 128) * 6144 + n;
#pragma unroll 16
        for (int k = 0; k < 128; ++k) { const float w = wm[(size_t)k * 6144];
#pragma unroll
            for (int b = 0; b < 33; ++b) acc[b] += s[b * 1024 + sl * 128 + k] * w; }
        __syncthreads();
#pragma unroll
        for (int b = 0; b < 33; ++b) s[(sl * 33 + b) * 64 + (tid & 63)] = acc[b];
        __syncthreads();
        float* mo = (float*)(ws + WS_MOD) + (size_t)l * 33 * 6144;
        for (int e = tid; e < 33 * 64; e += 512) { const int b = e >> 6, c = e & 63; float r = 0.f;
#pragma unroll
            for (int q = 0; q < 8; ++q) r += s[(q * 33 + b) * 64 + c];
            const int nn = (blockIdx.x % 96) * 64 + c;
            mo[(size_t)b * 6144 + nn] = r + a->in[I_BMOD][l * 6144 + nn]; }
        __syncthreads();
    } else {
        const int it = blockIdx.x - 192;
        if (it < 32) wpb_item(a, lds, it, tid);
    }
    for (int e = blockIdx.x * 512 + tid; e < 2048 * 32; e += gridDim.x * 512) {
        const int t = e >> 5, i = e & 31, p = i & 15; const int pos = i < 16 ? (t >> 6) : (t & 63);
        const int p4 = p & 3; double inv = p4 == 0 ? 1.0 : (p4 == 1 ? 0.5623413251903491 : (p4 == 2 ? 0.31622776601683794 : 0.1778279410038923));
        const int q4 = p >> 2; inv *= q4 == 0 ? 1.0 : (q4 == 1 ? 0.1 : (q4 == 2 ? 0.01 : 0.001));
        const double rev = (double)pos * inv * 0.15915494309189535; const float fr = (float)(rev - floor(rev));
        float2 cs; cs.x = __builtin_amdgcn_cosf(fr); cs.y = __builtin_amdgcn_sinf(fr);
        ((float2*)(ws + WS_ROPE))[e] = cs;
    }
    for (int l = 0; l < 2; ++l) {
        bf16_t* win = (bf16_t*)(ws + WS_W + l * W_LAYER + W_IN);
        for (int e = blockIdx.x * 512 + tid; e < (PW - INW) * D / 8; e += gridDim.x * 512) ((u32x4*)(win + (size_t)INW * D))[e] = (u32x4){0u, 0u, 0u, 0u};
    }
    {
        LAS float* scr = (LAS float*)(lds + 32768 + wave * 12288);
        const int gw = blockIdx.x * 8 + wave;
        const int nslot = gw < 1536 ? 1 : 2;
        for (int sl = 0; sl < nslot; ++sl)
            for (int it = gw < 1536 ? gw : 1536 + sl * 512 + (gw - 1536); it < T_PER_L; it += 2560) transpose_dispatch(a, scr, it, lane);
    }
}
__device__ __forceinline__ void late_weights(const __attribute__((address_space(4))) Args* a, LAS unsigned char* lds, const int wv) {
    const int tid = opq(wv * 64 + lane_id()), lane = tid & 63, wave = __builtin_amdgcn_readfirstlane(tid >> 6);
    const int vb = (int)blockIdx.x - 64;
    if (vb < 0) return;
    if (vb < 32) wpb_item(a, lds, 32 + vb, tid);
    LAS float* scr = (LAS float*)(lds + 32768 + wave * 12288);
    const int gw = vb * 8 + wave;
    const int nslot = gw < 256 ? 1 : 2;
    for (int sl = 0; sl < nslot; ++sl)
        for (int it = gw < 256 ? gw : 256 + sl * 1280 + (gw - 256); it < T_PER_L; it += 2816) transpose_dispatch(a, scr, T_PER_L + it, lane);
}

constexpr int LNR = 4;
__device__ __forceinline__ void ln_pass(int nrows, const float* s_lat, const float* s_ctx, float* d_lat, float* d_ctx,
                                        const float* g, const float* bta, const float* mod, int shoff, bf16_t* H, float* stats, const int wv) {
    const int tid_ = opq(wv * 64 + lane_id()), lane = tid_ & 63, nw = gridDim.x * 8;
    for (int row0 = LNR * (blockIdx.x * 8 + (tid_ >> 6)); row0 < nrows; row0 += LNR * nw) {
        const bool lat = row0 < NLAT;
        const float* sp = lat ? s_lat + (size_t)row0 * D : s_ctx + (size_t)(row0 - NLAT) * D;
        f32x4 v[LNR][4];
#pragma unroll
        for (int r = 0; r < LNR; ++r)
#pragma unroll
            for (int j = 0; j < 4; ++j) v[r][j] = __builtin_nontemporal_load((const f32x4*)(sp + r * D + j * 256 + lane * 4));
        f32x4 gg[4], bb[4];
        if (g) {
#pragma unroll
            for (int j = 0; j < 4; ++j) { gg[j] = *(const f32x4*)(g + j * 256 + lane * 4); bb[j] = *(const f32x4*)(bta + j * 256 + lane * 4); }
        }
        float mean[LNR], rstd[LNR];
#pragma unroll
        for (int r = 0; r < LNR; ++r) { float s = 0.f;
#pragma unroll
            for (int j = 0; j < 4; ++j) s += (v[r][j][0] + v[r][j][1]) + (v[r][j][2] + v[r][j][3]);
            mean[r] = wave_sum(s, lane) * (1.f / D); float s2 = 0.f;
#pragma unroll
            for (int j = 0; j < 4; ++j) { v[r][j] = v[r][j] - mean[r]; s2 += (v[r][j][0] * v[r][j][0] + v[r][j][1] * v[r][j][1]) + (v[r][j][2] * v[r][j][2] + v[r][j][3] * v[r][j][3]); }
            rstd[r] = 1.f / sqrtf(wave_sum(s2, lane) * (1.f / D) + LN_EPS); }
        if (g) {
            float* dp = lat ? d_lat + (size_t)row0 * D : d_ctx + (size_t)(row0 - NLAT) * D;
#pragma unroll
            for (int r = 0; r < LNR; ++r) { float s = 0.f;
                if (stats && lane == 0) { float2 sv; sv.x = mean[r]; sv.y = rstd[r]; ((float2*)stats)[row0 + r] = sv; }
#pragma unroll
                for (int j = 0; j < 4; ++j) { v[r][j] = v[r][j] * rstd[r] * gg[j] + bb[j]; if (!stats) *(f32x4*)(dp + r * D + j * 256 + lane * 4) = v[r][j]; s += (v[r][j][0] + v[r][j][1]) + (v[r][j][2] + v[r][j][3]); }
                if (H) {
                    mean[r] = wave_sum(s, lane) * (1.f / D); float s2 = 0.f;
#pragma unroll
                    for (int j = 0; j < 4; ++j) { v[r][j] = v[r][j] - mean[r]; s2 += (v[r][j][0] * v[r][j][0] + v[r][j][1] * v[r][j][1]) + (v[r][j][2] * v[r][j][2] + v[r][j][3] * v[r][j][3]); }
                    rstd[r] = 1.f / sqrtf(wave_sum(s2, lane) * (1.f / D) + LN_EPS);
                } }
        }
        if (H) {
            const float* mv = mod + (size_t)(lat ? (row0 >> 11) : 32) * 6144 + shoff;
#pragma unroll
            for (int j = 0; j < 4; ++j) { const f32x4 sh = *(const f32x4*)(mv + j * 256 + lane * 4), sc = *(const f32x4*)(mv + 1024 + j * 256 + lane * 4);
#pragma unroll
                for (int r = 0; r < LNR; ++r) { const f32x4 h = v[r][j] * rstd[r] * (sc + 1.f) + sh;
                    u32x2 w; w.x = pk2(h[0], h[1]); w.y = pk2(h[2], h[3]);
                    *(u32x2*)(H + (size_t)(row0 + r) * D + j * 256 + lane * 4) = w; } }
        }
    }
}

template <int GI>
__device__ __forceinline__ void pool_items(const bf16_t* P, bf16_t* U, int nrows, int gt, int nth) {
    constexpr int W = 2 << GI;
    for (int idx = gt; idx < nrows * 16; idx += nth) {
        const int row = idx >> 4, ch = GI * 16 + (idx & 15);
        int t, Ts;
        if (row < GLAT) { t = row & (T - 1); Ts = T; } else { t = (row - GLAT) & (CL - 1); Ts = CL; }
        const bf16_t* pp = P + (size_t)row * PW2 + P_POOL + ch * 8;
        u32x4 xs[W];
#pragma unroll
        for (int r = 0; r < W; ++r) { const int rr = t - W / 2 + r; const bool ok = rr >= 0 && rr < Ts;
            xs[r] = *(const u32x4*)(pp + (long)(ok ? r - W / 2 : 0) * PW2); if (!ok) xs[r] = (u32x4){0u, 0u, 0u, 0u}; }
        float sm[8];
#pragma unroll
        for (int j = 0; j < 8; ++j) sm[j] = 0.f;
#pragma unroll
        for (int r = 0; r < W; ++r)
#pragma unroll
            for (int j = 0; j < 4; ++j) { sm[2 * j] += bflo(xs[r][j]); sm[2 * j + 1] += bfhi(xs[r][j]); }
        const int lo = max(t - W / 2, 0), hi = min(t - W / 2 + W, Ts);
        const float inv = __builtin_amdgcn_rcpf((float)(hi - lo));
        const u32x4 x = xs[W / 2];
        u32x4 o;
#pragma unroll
        for (int j = 0; j < 4; ++j) o[j] = pk2(sm[2 * j] * inv - bflo(x[j]), sm[2 * j + 1] * inv - bfhi(x[j]));
        *(u32x4*)(U + (size_t)row * 1536 + ch * 8) = o;
    }
}
__device__ __forceinline__ void pool_phase(const bf16_t* P, bf16_t* U, bool with_ctx, const int wv) {
    const int gt = blockIdx.x * 512 + opq(wv * 64 + lane_id()), nth = gridDim.x * 512;
    const int nrows = with_ctx ? GTOK : GLAT;
    pool_items<0>(P, U, nrows, gt, nth); pool_items<1>(P, U, nrows, gt, nth); pool_items<2>(P, U, nrows, gt, nth); pool_items<3>(P, U, nrows, gt, nth);
}

typedef short v4i16_t __attribute__((ext_vector_type(4)));
__device__ __forceinline__ bf16x8 tr_frag(LAS unsigned char* base, int pitch, int krow, int ncol_bytes, int fr) {
    LAS unsigned char* p0 = base + (krow + (fr >> 2)) * pitch + ncol_bytes + 8 * (fr & 3);
    const v4i16_t lo = __builtin_amdgcn_ds_read_tr16_b64_v4i16((LAS v4i16_t*)p0);
    const v4i16_t hi = __builtin_amdgcn_ds_read_tr16_b64_v4i16((LAS v4i16_t*)(p0 + 4 * pitch));
    bf16x8 r; r[0] = lo[0]; r[1] = lo[1]; r[2] = lo[2]; r[3] = lo[3]; r[4] = hi[0]; r[5] = hi[1]; r[6] = hi[2]; r[7] = hi[3]; return r;
}
constexpr int ML_PITCH = 272;
constexpr int ML_R0 = 0, ML_R1 = 128 * ML_PITCH, ML_R2 = 2 * 128 * ML_PITCH, ML_R3 = ML_R2 + 144 * ML_PITCH, ML_GV = ML_R3 + 128 * ML_PITCH;
static_assert(ML_GV + 2 * 2048 <= LDS_BYTES - 64, "mlstm LDS map");

__device__ __forceinline__ void mlstm_gates(LAS float* gv, const float (&ig)[2], const float (&fgv)[2], int lane) {
    float lf[2];
#pragma unroll
    for (int e = 0; e < 2; ++e) { const float f = fgv[e]; lf[e] = f >= 0.f ? -__logf(1.f + __expf(-f)) : f - __logf(1.f + __expf(f)); }
    float x = lf[0] + lf[1];
#pragma unroll
    for (int o = 1; o < 64; o <<= 1) { const float t_ = shup(x, o, lane); if (lane >= o) x += t_; }
    const float b1 = x, b0 = x - lf[1], blast = shidx(x, 63);
    const float a0 = ig[0] - b0, a1 = ig[1] - b1;
    float pm = fmaxf(a0, a1);
#pragma unroll
    for (int o = 1; o < 64; o <<= 1) { const float t_ = shup(pm, o, lane); if (lane >= o) pm = fmaxf(pm, t_); }
    const float pprev = shup(pm, 1, lane);
    const float p0 = lane > 0 ? fmaxf(pprev, a0) : a0;
    const float amax = shidx(pm, 63);
    gv[2 * lane] = b0; gv[2 * lane + 1] = b1; gv[128 + 2 * lane] = a0; gv[128 + 2 * lane + 1] = a1; gv[256 + 2 * lane] = p0; gv[256 + 2 * lane + 1] = pm;
    if (lane == 0) { gv[384] = blast; gv[385] = blast + amax; }
}

__device__ __forceinline__ void mlstm_seq(LAS unsigned char* lds, const bf16_t* MQ, const bf16_t* IGF, bf16_t* Hm, int bl, int head, int dir, const float* mbi, const float* mbf, const int wv) {
    const int tid = opq(wv * 64 + lane_id()), w = __builtin_amdgcn_readfirstlane(tid >> 6), lane = tid & 63, fr = lane & 15, fq = lane >> 4;
    __syncthreads();
    f32x4 Cst[9];
#pragma unroll
    for (int vb = 0; vb < 9; ++vb) Cst[vb] = (f32x4){0.f, 0.f, 0.f, 0.f};
    float mst = 0.f;
    const float bi = mbi[dir * 4 + head], bf_ = mbf[dir * 4 + head];
    const int ip = tid >> 2, seg = tid & 3;
    const int gcol = dir * 4 + head;
    bf16x8 Vones;
#pragma unroll
    for (int j = 0; j < 8; ++j) Vones[j] = fr == 0 ? (short)0x3F80 : (short)0;
#define ML_BASE(ci) ((ci) < 2 ? GLAT + bl * CL + (dir ? 1 - (ci) : (ci)) * 128 : bl * T + (dir ? 15 - ((ci) - 2) : (ci) - 2) * 128)
    u32x4 qv[4], kv[4], vv[4];
    { const bf16_t* rp = MQ + ((size_t)head * GTOK + ML_BASE(0) + (dir ? 127 - ip : ip)) * 128 + seg * 32;
#pragma unroll
      for (int jj = 0; jj < 4; ++jj) { qv[jj] = *(const u32x4*)(rp + 8 * jj); kv[jj] = *(const u32x4*)(rp + (size_t)4 * GTOK * 128 + 8 * jj); vv[jj] = *(const u32x4*)(rp + (size_t)8 * GTOK * 128 + 8 * jj); } }
    if (w == 0) {
        float ig[2], fg[2];
#pragma unroll
        for (int e = 0; e < 2; ++e) { const int i2 = 2 * lane + e; const bf16_t* gp_ = IGF + (size_t)gcol * GTOK + ML_BASE(0) + (dir ? 127 - i2 : i2);
            ig[e] = bf2f(gp_[0]) + bi; fg[e] = bf2f(gp_[(size_t)8 * GTOK]) + bf_; }
        mlstm_gates((LAS float*)(lds + ML_GV), ig, fg, lane);
    }
    __syncthreads();
    for (int ci = 0; ci < 18; ++ci) {
        const int base_row = ML_BASE(ci);
        LAS float* gb = (LAS float*)(lds + ML_GV + (ci & 1) * 2048);
        const float blast = gb[384], gmax = gb[385];
        const float mnew = fmaxf(blast + mst, gmax), decay = __expf(blast + mst - mnew);
        { const float wk = __expf(blast + gb[128 + ip] - mnew) * 0.08838834764831845f;
#pragma unroll
          for (int jj = 0; jj < 4; ++jj) { u32x4 o;
#pragma unroll
            for (int e = 0; e < 4; ++e) o[e] = pk2(bflo(kv[jj][e]) * wk, bfhi(kv[jj][e]) * wk);
            *(LAS u32x4*)(lds + ML_R0 + ip * ML_PITCH + (seg * 32 + 8 * jj) * 2) = qv[jj];
            *(LAS u32x4*)(lds + ML_R1 + ip * ML_PITCH + (seg * 32 + 8 * jj) * 2) = o;
            *(LAS u32x4*)(lds + ML_R3 + ip * ML_PITCH + (seg * 32 + 8 * jj) * 2) = vv[jj]; } }
#pragma unroll
        for (int vb = 0; vb < 9; ++vb) { u32x2 cw; cw.x = pk2(Cst[vb][0], Cst[vb][1]); cw.y = pk2(Cst[vb][2], Cst[vb][3]);
            *(LAS u32x2*)(lds + ML_R2 + (16 * vb + fr) * ML_PITCH + (16 * w + 4 * fq) * 2) = cw; }
        float ign[2] = {0.f, 0.f}, fgn[2] = {0.f, 0.f};
        const int nbase = ML_BASE(ci + 1);
        if (ci + 1 < 18) {
            const bf16_t* rp = MQ + ((size_t)head * GTOK + nbase + (dir ? 127 - ip : ip)) * 128 + seg * 32;
#pragma unroll
            for (int jj = 0; jj < 4; ++jj) { qv[jj] = *(const u32x4*)(rp + 8 * jj); kv[jj] = *(const u32x4*)(rp + (size_t)4 * GTOK * 128 + 8 * jj); vv[jj] = *(const u32x4*)(rp + (size_t)8 * GTOK * 128 + 8 * jj); }
            if (w == 0) {
#pragma unroll
                for (int e = 0; e < 2; ++e) { const int i2 = 2 * lane + e; const bf16_t* gp_ = IGF + (size_t)gcol * GTOK + nbase + (dir ? 127 - i2 : i2);
                    ign[e] = bf2f(gp_[0]) + bi; fgn[e] = bf2f(gp_[(size_t)8 * GTOK]) + bf_; }
            }
        }
        __syncthreads();
        bf16x8 Qf[4];
#pragma unroll
        for (int kk = 0; kk < 4; ++kk) Qf[kk] = *(const LAS bf16x8*)(lds + ML_R0 + (16 * w + fr) * ML_PITCH + (32 * kk + 8 * fq) * 2);
        f32x4 S[8], A2[9];
#pragma unroll
        for (int tb = 0; tb < 8; ++tb) { S[tb] = (f32x4){0.f, 0.f, 0.f, 0.f};
#pragma unroll
            for (int kk = 0; kk < 4; ++kk) { const bf16x8 Kf = *(const LAS bf16x8*)(lds + ML_R1 + (16 * tb + fr) * ML_PITCH + (32 * kk + 8 * fq) * 2);
                S[tb] = __builtin_amdgcn_mfma_f32_16x16x32_bf16(Qf[kk], Kf, S[tb], 0, 0, 0); } }
#pragma unroll
        for (int vb = 0; vb < 9; ++vb) { A2[vb] = (f32x4){0.f, 0.f, 0.f, 0.f};
#pragma unroll
            for (int kk = 0; kk < 4; ++kk) { const bf16x8 Cf = *(const LAS bf16x8*)(lds + ML_R2 + (16 * vb + fr) * ML_PITCH + (32 * kk + 8 * fq) * 2);
                A2[vb] = __builtin_amdgcn_mfma_f32_16x16x32_bf16(Qf[kk], Cf, A2[vb], 0, 0, 0); } }
        float Mj[4], wint[4], bj[4], rowf[4];
#pragma unroll
        for (int i = 0; i < 4; ++i) { const int j = 16 * w + 4 * fq + i; bj[i] = gb[j]; Mj[i] = fmaxf(mst, gb[256 + j]); wint[i] = __expf(mst - Mj[i]); rowf[i] = __expf(mnew - blast - Mj[i]); }
        __syncthreads();
#pragma unroll
        for (int tb = 0; tb < 8; ++tb) { const int t = 16 * tb + fr;
#pragma unroll
            for (int i = 0; i < 4; ++i) { const int j = 16 * w + 4 * fq + i; const float v = t <= j ? S[tb][i] * rowf[i] : 0.f;
                *(LAS bf16_t*)(lds + ML_R0 + j * ML_PITCH + t * 2) = (bf16_t)f2bf(v); } }
        if (ci + 1 < 18 && w == 0) mlstm_gates((LAS float*)(lds + ML_GV + ((ci + 1) & 1) * 2048), ign, fgn, lane);
#pragma unroll
        for (int vb = 0; vb < 9; ++vb) {
#pragma unroll
            for (int i = 0; i < 4; ++i) { A2[vb][i] *= wint[i]; }
            Cst[vb] = Cst[vb] * decay; }
        __syncthreads();
#pragma unroll
        for (int kk = 0; kk < 4; ++kk) {
            const bf16x8 Sf = *(const LAS bf16x8*)(lds + ML_R0 + (16 * w + fr) * ML_PITCH + (32 * kk + 8 * fq) * 2);
            const bf16x8 Kwf = tr_frag(lds + ML_R1, ML_PITCH, 32 * kk + 8 * fq, 32 * w, fr);
#pragma unroll
            for (int vb = 0; vb < 9; ++vb) { const bf16x8 Vf = vb < 8 ? tr_frag(lds + ML_R3, ML_PITCH, 32 * kk + 8 * fq, 32 * vb, fr) : Vones;
                A2[vb] = __builtin_amdgcn_mfma_f32_16x16x32_bf16(Sf, Vf, A2[vb], 0, 0, 0);
                Cst[vb] = __builtin_amdgcn_mfma_f32_16x16x32_bf16(Kwf, Vf, Cst[vb], 0, 0, 0); }
        }
#pragma unroll
        for (int i = 0; i < 4; ++i) {
            const float nq = shidx(A2[8][i], lane & 48);
            const float den = fmaxf(fabsf(nq), __expf(-bj[i] - Mj[i]));
            const float rd = __builtin_amdgcn_rcpf(den);
            const int j = 16 * w + 4 * fq + i;
            bf16_t* hp = Hm + ((size_t)(dir * 4 + head) * GTOK + base_row + (dir ? 127 - j : j)) * 128 + fr;
#pragma unroll
            for (int vb = 0; vb < 8; ++vb) hp[16 * vb] = (bf16_t)f2bf(A2[vb][i] * rd);
        }
        mst = mnew;
        __syncthreads();
    }
#undef ML_BASE
}

constexpr int AT_KP = 144;
constexpr int AT_K = 0, AT_V = 384 * AT_KP;
static_assert(AT_V + 384 * AT_KP <= LDS_BYTES - 64, "attention LDS map");

__device__ __forceinline__ u32x4 rope8(u32x4 own, u32x4 par, const float2* cs, bool second) {
    u32x4 o;
#pragma unroll
    for (int j = 0; j < 4; ++j) { const float2 c0 = cs[2 * j], c1 = cs[2 * j + 1];
        const float s0 = second ? c0.y : -c0.y, s1 = second ? c1.y : -c1.y;
        o[j] = pk2(bflo(own[j]) * c0.x + bflo(par[j]) * s0, bfhi(own[j]) * c1.x + bfhi(par[j]) * s1); }
    return o;
}
__device__ __forceinline__ void attn_unit(LAS unsigned char* lds, const bf16_t* AQ, const bf16_t* AK, const bf16_t* AV, bf16_t* U, int bl, int hk, int qb, bool ctxq, const float* sink, const float2* rope, const int wv) {
    const int tid = opq(wv * 64 + lane_id()), w = __builtin_amdgcn_readfirstlane(tid >> 6), lane = tid & 63, fr = lane & 15, fq = lane >> 4;
    const int g = w >> 1, qh = hk * 4 + g, qoff = (w & 1) * 64;
    const int qrow0 = ctxq ? GLAT + bl * CL + qb * 128 : bl * T + qb * 128;
    bf16x8 Qf[4][2];
#pragma unroll
    for (int qt = 0; qt < 4; ++qt)
#pragma unroll
        for (int kk = 0; kk < 2; ++kk) {
            const bf16_t* qp = AQ + ((size_t)qh * GTOK + qrow0 + qoff + 16 * qt + fr) * 64 + 32 * kk + 8 * fq;
            u32x4 own = *(const u32x4*)qp;
            if (!ctxq) { const u32x4 par = *(const u32x4*)(qp + (fq < 2 ? 16 : -16));
                own = rope8(own, par, rope + (size_t)(qb * 128 + qoff + 16 * qt + fr) * 32 + kk * 16 + (fq & 1) * 8, fq >= 2); }
            Qf[qt][kk] = __builtin_bit_cast(bf16x8, own);
        }
    float mrun[4], lrun[4]; f32x4 O[4][4];
    constexpr float LOG2E = 1.4426950408889634f, C2 = 0.125f * LOG2E;
    const float sk = sink[hk * 4 + g] * LOG2E;
#pragma unroll
    for (int qt = 0; qt < 4; ++qt) { mrun[qt] = sk; lrun[qt] = fq == 0 ? 1.f : 0.f;
#pragma unroll
        for (int dv = 0; dv < 4; ++dv) O[dv][qt] = (f32x4){0.f, 0.f, 0.f, 0.f}; }
    for (int st = ctxq ? 1 : 0; st < 2; ++st) {
        const int nkeys = st == 0 ? 384 : 256;
        const int krow0 = st == 0 ? bl * T + qb * 128 - 128 : GLAT + bl * CL;
        const int rlo = st == 0 ? bl * T : krow0, rhi = st == 0 ? bl * T + T - 1 : krow0 + CL - 1;
        __syncthreads();
#pragma unroll 2
        for (int idx = tid; idx < nkeys * 8; idx += 512) {
            const int r = idx >> 3, ch = idx & 7; const int row = min(max(krow0 + r, rlo), rhi);
            const size_t so = ((size_t)hk * GTOK + row) * 64 + ch * 8;
            u32x4 kown = *(const u32x4*)(AK + so);
            const u32x4 vown = *(const u32x4*)(AV + so);
            if (st == 0) { const u32x4 par = *(const u32x4*)(AK + so + ((ch & 2) ? -16 : 16));
                kown = rope8(kown, par, rope + (size_t)(row & (T - 1)) * 32 + (ch >> 2) * 16 + (ch & 1) * 8, (ch & 2) != 0); }
            *(LAS u32x4*)(lds + AT_K + r * AT_KP + ch * 16) = kown;
            *(LAS u32x4*)(lds + AT_V + r * AT_KP + ch * 16) = vown;
        }
        __syncthreads();
        for (int c = 0; c < nkeys / 64; ++c) {
            if (st == 0 && (64 * c + 63 < qoff || 64 * c > qoff + 63 + 256)) continue;
            if (st == 0 && ((qb == 0 && c < 2) || (qb == 15 && c >= 4))) continue;
            const bool need_mask = st == 0 && !(64 * c >= qoff + 63 && 64 * c + 63 <= qoff + 256);
            f32x4 ST[4][4];
#pragma unroll
            for (int kt = 0; kt < 4; ++kt) {
                bf16x8 Kf[2];
#pragma unroll
                for (int kk = 0; kk < 2; ++kk) Kf[kk] = *(const LAS bf16x8*)(lds + AT_K + (64 * c + 16 * kt + fr) * AT_KP + (32 * kk + 8 * fq) * 2);
#pragma unroll
                for (int qt = 0; qt < 4; ++qt) { ST[kt][qt] = (f32x4){0.f, 0.f, 0.f, 0.f};
#pragma unroll
                    for (int kk = 0; kk < 2; ++kk) ST[kt][qt] = __builtin_amdgcn_mfma_f32_16x16x32_bf16(Kf[kk], Qf[qt][kk], ST[kt][qt], 0, 0, 0); }
            }
            if (need_mask) {
#pragma unroll
                for (int qt = 0; qt < 4; ++qt) { const int qi = qoff + 16 * qt + fr;
#pragma unroll
                    for (int kt = 0; kt < 4; ++kt)
#pragma unroll
                        for (int i = 0; i < 4; ++i) { const int kb = 64 * c + 16 * kt + 4 * fq + i; const int kpos = qb * 128 - 128 + kb;
                            const bool valid = kb >= qi && kb <= qi + 256 && kpos >= 0 && kpos < T; ST[kt][qt][i] = valid ? ST[kt][qt][i] : -INFINITY; } }
            }
            bf16x8 Pb[2][4];
#pragma unroll
            for (int qt = 0; qt < 4; ++qt) {
                float mx = max3f(ST[0][qt][0], ST[0][qt][1], ST[0][qt][2]);
                mx = max3f(mx, ST[0][qt][3], ST[1][qt][0]); mx = max3f(mx, ST[1][qt][1], ST[1][qt][2]); mx = max3f(mx, ST[1][qt][3], ST[2][qt][0]);
                mx = max3f(mx, ST[2][qt][1], ST[2][qt][2]); mx = max3f(mx, ST[2][qt][3], ST[3][qt][0]); mx = max3f(mx, ST[3][qt][1], ST[3][qt][2]);
                mx = max2f(mx, ST[3][qt][3]);
                mx *= C2;
                mx = max2f(mx, shx(mx, 16, lane)); mx = max2f(mx, shx(mx, 32, lane));
                const float mn = max2f(mrun[qt], mx);
                if (__builtin_amdgcn_ballot_w64(mn != mrun[qt]) != 0ull) {
                    const float alpha = __builtin_amdgcn_exp2f(mrun[qt] - mn);
                    lrun[qt] *= alpha;
#pragma unroll
                    for (int dv = 0; dv < 4; ++dv) O[dv][qt] = O[dv][qt] * alpha;
                    mrun[qt] = mn;
                }
                f32x2 ps2 = (f32x2){0.f, 0.f}; unsigned pw[8];
                const f32x2 c2v = (f32x2){C2, C2}, mnv = (f32x2){mn, mn};
#pragma unroll
                for (int kt = 0; kt < 4; ++kt) {
                    const f32x2 a0 = (f32x2){ST[kt][qt][0], ST[kt][qt][1]} * c2v - mnv, a1 = (f32x2){ST[kt][qt][2], ST[kt][qt][3]} * c2v - mnv;
                    f32x2 q0, q1; q0.x = __builtin_amdgcn_exp2f(a0.x); q0.y = __builtin_amdgcn_exp2f(a0.y); q1.x = __builtin_amdgcn_exp2f(a1.x); q1.y = __builtin_amdgcn_exp2f(a1.y);
                    ps2 += q0; ps2 += q1; pw[2 * kt] = pk2(q0.x, q0.y); pw[2 * kt + 1] = pk2(q1.x, q1.y);
                }
                lrun[qt] += ps2.x + ps2.y;
                u32x4 w0; w0.x = pw[0]; w0.y = pw[1]; w0.z = pw[2]; w0.w = pw[3];
                u32x4 w1; w1.x = pw[4]; w1.y = pw[5]; w1.z = pw[6]; w1.w = pw[7];
                Pb[0][qt] = __builtin_bit_cast(bf16x8, w0); Pb[1][qt] = __builtin_bit_cast(bf16x8, w1);
            }
#pragma unroll
            for (int h = 0; h < 2; ++h)
#pragma unroll
            for (int dv = 0; dv < 4; ++dv) {
                LAS unsigned char* vp = lds + AT_V + (64 * c + 32 * h + 4 * fq + (fr >> 2)) * AT_KP + 32 * dv + 8 * (fr & 3);
                const v4i16_t vlo = __builtin_amdgcn_ds_read_tr16_b64_v4i16((LAS v4i16_t*)vp), vhi = __builtin_amdgcn_ds_read_tr16_b64_v4i16((LAS v4i16_t*)(vp + 16 * AT_KP));
                bf16x8 Vf; Vf[0] = vlo[0]; Vf[1] = vlo[1]; Vf[2] = vlo[2]; Vf[3] = vlo[3]; Vf[4] = vhi[0]; Vf[5] = vhi[1]; Vf[6] = vhi[2]; Vf[7] = vhi[3];
#pragma unroll
                for (int qt = 0; qt < 4; ++qt) O[dv][qt] = __builtin_amdgcn_mfma_f32_16x16x32_bf16(Vf, Pb[h][qt], O[dv][qt], 0, 0, 0);
            }
        }
    }
#pragma unroll
    for (int qt = 0; qt < 4; ++qt) {
        float l = lrun[qt]; l += shx(l, 16, lane); l += shx(l, 32, lane);
        const float rl = 1.f / l;
        bf16_t* op = U + (size_t)(qrow0 + qoff + 16 * qt + fr) * 1536 + 1024 + qh * 64 + 4 * fq;
#pragma unroll
        for (int dv = 0; dv < 4; ++dv) { u32x2 o; o.x = pk2(O[dv][qt][0] * rl, O[dv][qt][1] * rl); o.y = pk2(O[dv][qt][2] * rl, O[dv][qt][3] * rl);
            *(u32x2*)(op + 16 * dv) = o; }
    }
}

__device__ __forceinline__ void readout_phase(const bf16_t* P, const bf16_t* Hm, bf16_t* U, const float* normw, int nrows, const int wv) {
    const int tid_ = opq(wv * 64 + lane_id()), lane = tid_ & 63, nw = gridDim.x * 8;
    const f32x4 w0 = *(const f32x4*)(normw + lane * 8), w1 = *(const f32x4*)(normw + lane * 8 + 4);
    for (int row0 = 2 * (blockIdx.x * 8 + (tid_ >> 6)); row0 < nrows; row0 += 2 * nw) {
        u32x4 h0[2], h1[2], og[2];
#pragma unroll
        for (int r = 0; r < 2; ++r) { const size_t ho = ((size_t)(lane >> 4) * GTOK + row0 + r) * 128 + (lane & 15) * 8;
            h0[r] = *(const u32x4*)(Hm + ho); h1[r] = *(const u32x4*)(Hm + (size_t)4 * GTOK * 128 + ho);
            og[r] = *(const u32x4*)(P + (size_t)(row0 + r) * PW2 + P_OM + lane * 8); }
#pragma unroll
        for (int r = 0; r < 2; ++r) {
            float v[8]; float s = 0.f;
#pragma unroll
            for (int j = 0; j < 4; ++j) { v[2 * j] = bflo(h0[r][j]) + bflo(h1[r][j]); v[2 * j + 1] = bfhi(h0[r][j]) + bfhi(h1[r][j]); s += v[2 * j] + v[2 * j + 1]; }
#pragma unroll
            for (int o = 1; o < 16; o <<= 1) s += shx(s, o, lane);
            const float mu = s * (1.f / 128.f); float s2 = 0.f;
#pragma unroll
            for (int j = 0; j < 8; ++j) { v[j] -= mu; s2 += v[j] * v[j]; }
#pragma unroll
            for (int o = 1; o < 16; o <<= 1) s2 += shx(s2, o, lane);
            const float rstd = 1.f / sqrtf(s2 * (1.f / 128.f) + LN_EPS);
            float o_[8];
#pragma unroll
            for (int j = 0; j < 4; ++j) { o_[2 * j] = sigmoidf_(bflo(og[r][j])); o_[2 * j + 1] = sigmoidf_(bfhi(og[r][j])); }
            u32x4 q;
            q.x = pk2(v[0] * rstd * w0[0] * o_[0], v[1] * rstd * w0[1] * o_[1]); q.y = pk2(v[2] * rstd * w0[2] * o_[2], v[3] * rstd * w0[3] * o_[3]);
            q.z = pk2(v[4] * rstd * w1[0] * o_[4], v[5] * rstd * w1[1] * o_[5]); q.w = pk2(v[6] * rstd * w1[2] * o_[6], v[7] * rstd * w1[3] * o_[7]);
            *(u32x4*)(U + (size_t)(row0 + r) * 1536 + 512 + lane * 8) = q;
        }
    }
}

#define XB_TMO      128
#define XB_XCNT(j)  (256  + 64 * (j))
#define XB_XSUB(j)  (1280 + 64 * (j))
#define XB_XGEN(j)  (2304 + 64 * (j))
#define XB_TOP      3328
#define XB_TOPGEN   3392
#define XCD_BAR_WORDS 3456
#define XB_SPIN_CAP (1u << 18)
__device__ __forceinline__ unsigned xb_ld(unsigned* p)              { return __hip_atomic_load(p, __ATOMIC_RELAXED, __HIP_MEMORY_SCOPE_AGENT); }
__device__ __forceinline__ unsigned xb_add(unsigned* p, unsigned v) { return __hip_atomic_fetch_add(p, v, __ATOMIC_RELAXED, __HIP_MEMORY_SCOPE_AGENT); }
__device__ __forceinline__ unsigned xb_xcc_id() { return (unsigned)__builtin_amdgcn_s_getreg((3 << 11) | 20) & 0xFu; }
#define XB_SPIN(cond, bar) do { unsigned _sp = 0; while (cond) { __builtin_amdgcn_s_sleep(1); \
    if ((++_sp & 255u) == 0u) { if (xb_ld(&(bar)[XB_TMO])) break; if (_sp > XB_SPIN_CAP) { atomicAdd(&(bar)[XB_TMO], 1u); break; } } } } while (0)
__device__ __forceinline__ void xcd_barrier_complete(unsigned* bar, unsigned x, unsigned& nloc, unsigned& nx) {
    const unsigned G = gridDim.x * gridDim.y * gridDim.z;
    unsigned sum, cnt, mine, sp = 0u;
    for (;;) {
        sum = 0u; cnt = 0u; mine = 0u;
#pragma unroll
        for (unsigned j = 0; j < 16; ++j) { const unsigned c = xb_ld(&bar[XB_XCNT(j)]); sum += c; cnt += (c > 0u) ? 1u : 0u; mine = (j == x) ? c : mine; }
        if (sum == G) break;
        __builtin_amdgcn_s_sleep(1);
        if ((++sp & 255u) == 0u) { if (xb_ld(&bar[XB_TMO])) break; if (sp > XB_SPIN_CAP) { atomicAdd(&bar[XB_TMO], 1u); break; } }
    }
    nloc = mine > 0u ? mine : 1u; nx = cnt > 0u ? cnt : 1u;
}
__device__ __forceinline__ void xcd_barrier(unsigned* bar, volatile LAS unsigned* st, const int wv) {
    asm volatile("s_waitcnt vmcnt(0)" ::: "memory");
    __syncthreads();
    if (wv == 0 && lane_id() == 0) {
        const unsigned x = xb_xcc_id();
        __builtin_amdgcn_s_waitcnt(0);
        unsigned nloc = st[0], nx = st[1];
        if (nloc == 0u) { xcd_barrier_complete(bar, x, nloc, nx); st[0] = nloc; st[1] = nx; }
        const unsigned old = xb_add(&bar[XB_XSUB(x)], 1u);
        const unsigned gen = old / nloc;
        if (old + 1u == (gen + 1u) * nloc) {
            __builtin_amdgcn_fence(__ATOMIC_RELEASE, "agent");
            asm volatile("s_waitcnt vmcnt(0)" ::: "memory");
            const unsigned og = xb_add(&bar[XB_TOP], 1u);
            const unsigned tg = og / nx;
            if (og + 1u == (tg + 1u) * nx) xb_add(&bar[XB_TOPGEN], 1u);
            else XB_SPIN(xb_ld(&bar[XB_TOPGEN]) == tg, bar);
            __builtin_amdgcn_fence(__ATOMIC_ACQUIRE, "agent");
            xb_add(&bar[XB_XGEN(x)], 1u);
            asm volatile("s_waitcnt vmcnt(0)" ::: "memory");
        } else {
            XB_SPIN(xb_ld(&bar[XB_XGEN(x)]) == gen, bar);
            __builtin_amdgcn_fence(__ATOMIC_ACQUIRE, "agent");
            asm volatile("s_waitcnt vmcnt(0)" ::: "memory");
        }
    }
    __syncthreads();
}

typedef const __attribute__((address_space(4))) Args* KArgP;
__device__ __forceinline__ KArgP kargs() { KArgP p = (KArgP)__builtin_amdgcn_kernarg_segment_ptr(); asm volatile("" : "+s"(p)); return p; }
#define PHASE_ENV(lv, gv) \
    KArgP a = kargs(); unsigned char* ws = a->ws; const int l = opqs(lv), g = opqs(gv); const bool last = (l == 1); (void)g; (void)last; \
    const int G = gridDim.x, bx = blockIdx.x; (void)G; (void)bx; \
    float* mod = (float*)(ws + WS_MOD); float* ctxx = (float*)(ws + WS_CTXX); (void)ctxx; \
    bf16_t* H = (bf16_t*)(ws + WS_H); bf16_t* P = (bf16_t*)(ws + WS_P); bf16_t* ACT = (bf16_t*)(ws + WS_P); (void)H; (void)P; (void)ACT; \
    bf16_t* U = (bf16_t*)(ws + WS_U); bf16_t* Y = (bf16_t*)(ws + WS_Y); bf16_t* Hm = (bf16_t*)(ws + WS_Y); (void)U; (void)Y; (void)Hm; \
    const unsigned char* wl = ws + WS_W + l * W_LAYER; (void)wl; const float* modl = mod + (size_t)l * 33 * 6144; (void)modl;

__global__ void __launch_bounds__(512, 2) fwd_kernel(Args a_unused) {
    extern __shared__ __attribute__((aligned(16))) unsigned char lds_raw[];
    LAS unsigned char* lds = (LAS unsigned char*)lds_raw;
    cg::grid_group grid = cg::this_grid();
    const int wv = __builtin_amdgcn_readfirstlane(threadIdx.x >> 6);
#define XB_ST ((volatile LAS unsigned*)(lds + LDS_BYTES - 32))
#define GSYNC() do { KArgP a_ = kargs(); xcd_barrier((unsigned*)(a_->ws + WS_CTL) + 4096, XB_ST, wv); } while (0)
    if (wv == 0 && lane_id() < 2) XB_ST[lane_id()] = 0u;
    __syncthreads();
    if (wv == 0 && lane_id() == 0) { KArgP a_ = kargs(); (void)xb_add((unsigned*)(a_->ws + WS_CTL) + 4096 + XB_XCNT(xb_xcc_id()), 1u); }

    { KArgP a = kargs(); prologue(a, lds, wv); }
    { KArgP a_ = kargs(); if (a_->ws == nullptr) grid.sync(); }
    GSYNC();
    { PHASE_ENV(0, 0); ln_pass(NTOK, a->in[I_X], a->in[I_CTX], nullptr, nullptr, nullptr, nullptr, mod, 0, H, nullptr, wv); }
    GSYNC();

    {
            { PHASE_ENV(0, 0);
              pg8::Sched S; S.nseg = 1; S.G = G; S.c = bx; S.s0.A = (const char*)H; S.s0.Bt = (const char*)(wl + W_IN); S.s0.a_tile = (size_t)256 * D * 2; S.s0.b_tile = (size_t)256 * D * 2; S.s0.nM = 144; S.s0.nN = PW / 256; S.s0.nwg = S.s0.nM * S.s0.nN; S.s0.lat_n = 128; S.s0.a_lat = 128 * g; S.s0.a_ctx = 256 + 16 * g; S.s0.o_lat = 0; S.s0.o_ctx = 128; S.s0.pbmap = 0; S.s1 = S.s0;
              pg8::EpiP E{P, (bf16_t*)(ws + WS_MQ), (bf16_t*)(ws + WS_AQ), (bf16_t*)(ws + WS_AK), (bf16_t*)(ws + WS_AV), (bf16_t*)(ws + WS_IGF)};
              pg8::gemm_phase<pg8::EpiP, D, D, D>(lds, S, E, wv); }
            GSYNC();
            { PHASE_ENV(0, 0);
                if (bx < GB * 8) mlstm_seq(lds, (const bf16_t*)(ws + WS_MQ), (const bf16_t*)(ws + WS_IGF), Hm, bx >> 3, (bx >> 1) & 3, bx & 1, a->in[I_MBI] + l * 8, a->in[I_MBF] + l * 8, wv);
                const int nunits = GB * 32 + (last ? 0 : GB * 4);
                unsigned* ctr = (unsigned*)(ws + WS_CTL) + 64 * (1 + l * NG + g);
                const float2* rope = (const float2*)(ws + WS_ROPE);
                LAS unsigned* slot = (LAS unsigned*)(lds + LDS_BYTES - 64);
                for (;;) {
                    __syncthreads();
                    if (wv == 0 && lane_id() == 0) *slot = atomicAdd(ctr, 1u);
                    __syncthreads();
                    const int un = (int)*slot;
                    if (un >= nunits) break;
                    if (un < GB * 32) attn_unit(lds, (const bf16_t*)(ws + WS_AQ), (const bf16_t*)(ws + WS_AK), (const bf16_t*)(ws + WS_AV), U, un >> 5, (un >> 4) & 1, un & 15, false, a->in[I_SINK] + l * 8, rope, wv);
                    else { const int r = un - GB * 32; attn_unit(lds, (const bf16_t*)(ws + WS_AQ), (const bf16_t*)(ws + WS_AK), (const bf16_t*)(ws + WS_AV), U, r >> 2, (r >> 1) & 1, r & 1, true, a->in[I_SINK] + l * 8, rope, wv); }
                }
            }
            GSYNC();
            { PHASE_ENV(0, 0);
              readout_phase(P, Hm, U, a->in[I_MNORM] + l * 512, last ? GLAT : GTOK, wv);
              pool_phase(P, U, !last, wv); }
            GSYNC();
            { PHASE_ENV(0, 0);
              pg8::Sched S; S.nseg = 1; S.G = G; S.c = bx; S.s0.A = (const char*)U; S.s0.Bt = (const char*)(wl + W_BR); S.s0.a_tile = (size_t)256 * 1536 * 2; S.s0.b_tile = (size_t)256 * 1536 * 2; S.s0.nM = last ? 128 : 144; S.s0.nN = 4; S.s0.nwg = S.s0.nM * S.s0.nN; S.s0.lat_n = 128; S.s0.a_lat = 0; S.s0.a_ctx = 128; S.s0.o_lat = 0; S.s0.o_ctx = 128; S.s0.pbmap = 0; S.s1 = S.s0;
              pg8::EpiMerge E{P, Y};
              pg8::gemm_phase<pg8::EpiMerge, 1536, 1536, 1536>(lds, S, E, wv);
              late_weights(a, lds, wv); }
            GSYNC();
    }
    {
            { PHASE_ENV(0, 1);
              const float* xs_lat = l == 0 ? a->in[I_X] : a->out; const float* xs_ctx = l == 0 ? a->in[I_CTX] : ctxx;
              pg8::Sched S; S.nseg = 2; S.G = G; S.c = bx;
              S.s0.A = (const char*)Y; S.s0.Bt = (const char*)(wl + W_OUT); S.s0.a_tile = (size_t)256 * D * 2; S.s0.b_tile = (size_t)256 * D * 2; S.s0.nM = last ? 128 : 144; S.s0.nN = 4; S.s0.nwg = S.s0.nM * S.s0.nN;
              S.s0.lat_n = 128; S.s0.a_lat = 0; S.s0.a_ctx = 128; S.s0.o_lat = 0; S.s0.o_ctx = 256; S.s0.pbmap = 0;
              S.s1.A = (const char*)H; S.s1.Bt = (const char*)(wl + W_IN); S.s1.a_tile = (size_t)256 * D * 2; S.s1.b_tile = (size_t)256 * D * 2; S.s1.nM = 144; S.s1.nN = PW / 256; S.s1.nwg = S.s1.nM * S.s1.nN;
              S.s1.lat_n = 128; S.s1.a_lat = 128; S.s1.a_ctx = 256 + 16; S.s1.o_lat = 0; S.s1.o_ctx = 128; S.s1.pbmap = 0;
              pg8::EpiDual E{pg8::EpiRes{xs_lat, xs_ctx, a->out, ctxx, modl + 2048, l == 0 ? nullptr : (const float*)(ws + WS_STATS), a->in[I_LN2G], a->in[I_LN2B]},
                             pg8::EpiP{P, (bf16_t*)(ws + WS_MQ), (bf16_t*)(ws + WS_AQ), (bf16_t*)(ws + WS_AK), (bf16_t*)(ws + WS_AV), (bf16_t*)(ws + WS_IGF)}};
              pg8::gemm_phase<pg8::EpiDual, D, D, D>(lds, S, E, wv); }
            GSYNC();
            { PHASE_ENV(0, 1);
                if (bx < GB * 8) mlstm_seq(lds, (const bf16_t*)(ws + WS_MQ), (const bf16_t*)(ws + WS_IGF), Hm, bx >> 3, (bx >> 1) & 3, bx & 1, a->in[I_MBI] + l * 8, a->in[I_MBF] + l * 8, wv);
                const int nunits = GB * 32 + (last ? 0 : GB * 4);
                unsigned* ctr = (unsigned*)(ws + WS_CTL) + 64 * (1 + l * NG + g);
                const float2* rope = (const float2*)(ws + WS_ROPE);
                LAS unsigned* slot = (LAS unsigned*)(lds + LDS_BYTES - 64);
                for (;;) {
                    __syncthreads();
                    if (wv == 0 && lane_id() == 0) *slot = atomicAdd(ctr, 1u);
                    __syncthreads();
                    const int un = (int)*slot;
                    if (un >= nunits) break;
                    if (un < GB * 32) attn_unit(lds, (const bf16_t*)(ws + WS_AQ), (const bf16_t*)(ws + WS_AK), (const bf16_t*)(ws + WS_AV), U, un >> 5, (un >> 4) & 1, un & 15, false, a->in[I_SINK] + l * 8, rope, wv);
                    else { const int r = un - GB * 32; attn_unit(lds, (const bf16_t*)(ws + WS_AQ), (const bf16_t*)(ws + WS_AK), (const bf16_t*)(ws + WS_AV), U, r >> 2, (r >> 1) & 1, r & 1, true, a->in[I_SINK] + l * 8, rope, wv); }
                }
            }
            GSYNC();
            { PHASE_ENV(0, 1);
              readout_phase(P, Hm, U, a->in[I_MNORM] + l * 512, last ? GLAT : GTOK, wv);
              pool_phase(P, U, !last, wv); }
            GSYNC();
            { PHASE_ENV(0, 1);
              pg8::Sched S; S.nseg = 1; S.G = G; S.c = bx; S.s0.A = (const char*)U; S.s0.Bt = (const char*)(wl + W_BR); S.s0.a_tile = (size_t)256 * 1536 * 2; S.s0.b_tile = (size_t)256 * 1536 * 2; S.s0.nM = last ? 128 : 144; S.s0.nN = 4; S.s0.nwg = S.s0.nM * S.s0.nN; S.s0.lat_n = 128; S.s0.a_lat = 0; S.s0.a_ctx = 128; S.s0.o_lat = 0; S.s0.o_ctx = 128; S.s0.pbmap = 0; S.s1 = S.s0;
              pg8::EpiMerge E{P, Y};
              pg8::gemm_phase<pg8::EpiMerge, 1536, 1536, 1536>(lds, S, E, wv); }
            GSYNC();
            { PHASE_ENV(0, 1);
              const float* xs_lat = l == 0 ? a->in[I_X] : a->out; const float* xs_ctx = l == 0 ? a->in[I_CTX] : ctxx;
              pg8::Sched S; S.nseg = 1; S.G = G; S.c = bx; S.s0.A = (const char*)Y; S.s0.Bt = (const char*)(wl + W_OUT); S.s0.a_tile = (size_t)256 * D * 2; S.s0.b_tile = (size_t)256 * D * 2; S.s0.nM = last ? 128 : 144; S.s0.nN = 4; S.s0.nwg = S.s0.nM * S.s0.nN; S.s0.lat_n = 128; S.s0.a_lat = 0; S.s0.a_ctx = 128; S.s0.o_lat = 128 * g; S.s0.o_ctx = 256 + 16 * g; S.s0.pbmap = 0; S.s1 = S.s0;
              pg8::EpiRes E{xs_lat, xs_ctx, a->out, ctxx, modl + 2048, l == 0 ? nullptr : (const float*)(ws + WS_STATS), a->in[I_LN2G], a->in[I_LN2B]};
              pg8::gemm_phase<pg8::EpiRes, D, D, D>(lds, S, E, wv); }
            GSYNC();
    }
    {
        { PHASE_ENV(0, 0);
          ln_pass(last ? NLAT : NTOK, a->out, ctxx, a->out, ctxx, a->in[I_LN1G] + l * D, a->in[I_LN1B] + l * D, modl, 3072, H, (float*)(ws + WS_STATS), wv); }
        GSYNC();
        { PHASE_ENV(0, 0);
          pg8::Sched S; S.nseg = 1; S.G = G; S.c = bx; S.s0.A = (const char*)H; S.s0.Bt = (const char*)(wl + W_GU); S.s0.a_tile = (size_t)256 * D * 2; S.s0.b_tile = (size_t)256 * D * 2; S.s0.nM = last ? 256 : 288; S.s0.nN = 22; S.s0.nwg = S.s0.nM * S.s0.nN; S.s0.lat_n = 1 << 20; S.s0.a_lat = 0; S.s0.a_ctx = 0; S.s0.o_lat = 0; S.s0.o_ctx = 0; S.s0.pbmap = 0; S.s1 = S.s0;
          pg8::EpiUp E{ACT};
          pg8::gemm_phase<pg8::EpiUp, D, D, D>(lds, S, E, wv); }
        GSYNC();
        { PHASE_ENV(0, 0);
          pg8::Sched S; S.nseg = 1; S.G = G; S.c = bx; S.s0.A = (const char*)ACT; S.s0.Bt = (const char*)(wl + W_DN); S.s0.a_tile = (size_t)256 * DFF * 2; S.s0.b_tile = (size_t)256 * DFF * 2; S.s0.nM = last ? 256 : 288; S.s0.nN = 4; S.s0.nwg = S.s0.nM * S.s0.nN; S.s0.lat_n = 1 << 20; S.s0.a_lat = 0; S.s0.a_ctx = 0; S.s0.o_lat = 0; S.s0.o_ctx = 0; S.s0.pbmap = 0; S.s1 = S.s0;
          pg8::EpiRes E{a->out, ctxx, a->out, ctxx, modl + 5120, (const float*)(ws + WS_STATS), a->in[I_LN1G] + l * D, a->in[I_LN1B] + l * D};
          pg8::gemm_phase<pg8::EpiRes, DFF, DFF, DFF>(lds, S, E, wv); }
        GSYNC();
        { PHASE_ENV(0, 0);
          ln_pass(last ? NLAT : NTOK, a->out, ctxx, a->out, ctxx, a->in[I_LN2G] + l * D, a->in[I_LN2B] + l * D, last ? nullptr : modl + (size_t)33 * 6144, 0, last ? nullptr : H, last ? nullptr : (float*)(ws + WS_STATS), wv); }
    }
    GSYNC();
    {
            { PHASE_ENV(1, 0);
              pg8::Sched S; S.nseg = 2; S.G = G; S.c = bx; S.s0.A = (const char*)H; S.s0.Bt = (const char*)(wl + W_IN); S.s0.a_tile = (size_t)256 * D * 2; S.s0.b_tile = (size_t)256 * D * 2; S.s0.nM = 128; S.s0.nN = PW / 256; S.s0.nwg = S.s0.nM * S.s0.nN;
              S.s0.lat_n = 128; S.s0.a_lat = 0; S.s0.a_ctx = 256; S.s0.o_lat = 0; S.s0.o_ctx = 128; S.s0.pbmap = 0;
              S.s1 = S.s0; S.s1.nM = 16; S.s1.nN = 8; S.s1.nwg = 128; S.s1.lat_n = 0; S.s1.pbmap = 1;
              pg8::EpiP E{P, (bf16_t*)(ws + WS_MQ), (bf16_t*)(ws + WS_AQ), (bf16_t*)(ws + WS_AK), (bf16_t*)(ws + WS_AV), (bf16_t*)(ws + WS_IGF)};
              pg8::gemm_phase<pg8::EpiP, D, D, D>(lds, S, E, wv); }
            GSYNC();
            { PHASE_ENV(1, 0);
                if (bx < GB * 8) mlstm_seq(lds, (const bf16_t*)(ws + WS_MQ), (const bf16_t*)(ws + WS_IGF), Hm, bx >> 3, (bx >> 1) & 3, bx & 1, a->in[I_MBI] + l * 8, a->in[I_MBF] + l * 8, wv);
                const int nunits = GB * 32 + (last ? 0 : GB * 4);
                unsigned* ctr = (unsigned*)(ws + WS_CTL) + 64 * (1 + l * NG + g);
                const float2* rope = (const float2*)(ws + WS_ROPE);
                LAS unsigned* slot = (LAS unsigned*)(lds + LDS_BYTES - 64);
                for (;;) {
                    __syncthreads();
                    if (wv == 0 && lane_id() == 0) *slot = atomicAdd(ctr, 1u);
                    __syncthreads();
                    const int un = (int)*slot;
                    if (un >= nunits) break;
                    if (un < GB * 32) attn_unit(lds, (const bf16_t*)(ws + WS_AQ), (const bf16_t*)(ws + WS_AK), (const bf16_t*)(ws + WS_AV), U, un >> 5, (un >> 4) & 1, un & 15, false, a->in[I_SINK] + l * 8, rope, wv);
                    else { const int r = un - GB * 32; attn_unit(lds, (const bf16_t*)(ws + WS_AQ), (const bf16_t*)(ws + WS_AK), (const bf16_t*)(ws + WS_AV), U, r >> 2, (r >> 1) & 1, r & 1, true, a->in[I_SINK] + l * 8, rope, wv); }
                }
            }
            GSYNC();
            { PHASE_ENV(1, 0);
              readout_phase(P, Hm, U, a->in[I_MNORM] + l * 512, last ? GLAT : GTOK, wv);
              pool_phase(P, U, !last, wv); }
            GSYNC();
            { PHASE_ENV(1, 0);
              pg8::Sched S; S.nseg = 1; S.G = G; S.c = bx; S.s0.A = (const char*)U; S.s0.Bt = (const char*)(wl + W_BR); S.s0.a_tile = (size_t)256 * 1536 * 2; S.s0.b_tile = (size_t)256 * 1536 * 2; S.s0.nM = last ? 128 : 144; S.s0.nN = 4; S.s0.nwg = S.s0.nM * S.s0.nN; S.s0.lat_n = 128; S.s0.a_lat = 0; S.s0.a_ctx = 128; S.s0.o_lat = 0; S.s0.o_ctx = 128; S.s0.pbmap = 0; S.s1 = S.s0;
              pg8::EpiMerge E{P, Y};
              pg8::gemm_phase<pg8::EpiMerge, 1536, 1536, 1536>(lds, S, E, wv); }
            GSYNC();
    }
    {
            { PHASE_ENV(1, 0);
              pg8::Sched S; S.nseg = 1; S.G = G; S.c = bx; S.s0.A = (const char*)Y; S.s0.Bt = (const char*)(wl + W_OUT); S.s0.a_tile = (size_t)256 * D * 2; S.s0.b_tile = (size_t)256 * D * 2; S.s0.nM = 128; S.s0.nN = 4; S.s0.nwg = S.s0.nM * S.s0.nN;
              S.s0.lat_n = 128; S.s0.a_lat = 0; S.s0.a_ctx = 128; S.s0.o_lat = 0; S.s0.o_ctx = 256; S.s0.pbmap = 0; S.s1 = S.s0;
              pg8::EpiRes E{a->out, ctxx, a->out, ctxx, modl + 2048, (const float*)(ws + WS_STATS), a->in[I_LN2G], a->in[I_LN2B]};
              pg8::gemm_phase<pg8::EpiRes, D, D, D>(lds, S, E, wv); }
            GSYNC();
            { PHASE_ENV(1, 1);
              pg8::Sched S; S.nseg = 2; S.G = G; S.c = bx; S.s0.A = (const char*)H; S.s0.Bt = (const char*)(wl + W_IN); S.s0.a_tile = (size_t)256 * D * 2; S.s0.b_tile = (size_t)256 * D * 2; S.s0.nM = 128; S.s0.nN = PW / 256; S.s0.nwg = S.s0.nM * S.s0.nN;
              S.s0.lat_n = 128; S.s0.a_lat = 128; S.s0.a_ctx = 256 + 16; S.s0.o_lat = 0; S.s0.o_ctx = 128; S.s0.pbmap = 0;
              S.s1 = S.s0; S.s1.nM = 16; S.s1.nN = 8; S.s1.nwg = 128; S.s1.lat_n = 0; S.s1.pbmap = 1;
              pg8::EpiP E{P, (bf16_t*)(ws + WS_MQ), (bf16_t*)(ws + WS_AQ), (bf16_t*)(ws + WS_AK), (bf16_t*)(ws + WS_AV), (bf16_t*)(ws + WS_IGF)};
              pg8::gemm_phase<pg8::EpiP, D, D, D>(lds, S, E, wv); }
            GSYNC();
            { PHASE_ENV(1, 1);
                if (bx < GB * 8) mlstm_seq(lds, (const bf16_t*)(ws + WS_MQ), (const bf16_t*)(ws + WS_IGF), Hm, bx >> 3, (bx >> 1) & 3, bx & 1, a->in[I_MBI] + l * 8, a->in[I_MBF] + l * 8, wv);
                const int nunits = GB * 32 + (last ? 0 : GB * 4);
                unsigned* ctr = (unsigned*)(ws + WS_CTL) + 64 * (1 + l * NG + g);
                const float2* rope = (const float2*)(ws + WS_ROPE);
                LAS unsigned* slot = (LAS unsigned*)(lds + LDS_BYTES - 64);
                for (;;) {
                    __syncthreads();
                    if (wv == 0 && lane_id() == 0) *slot = atomicAdd(ctr, 1u);
                    __syncthreads();
                    const int un = (int)*slot;
                    if (un >= nunits) break;
                    if (un < GB * 32) attn_unit(lds, (const bf16_t*)(ws + WS_AQ), (const bf16_t*)(ws + WS_AK), (const bf16_t*)(ws + WS_AV), U, un >> 5, (un >> 4) & 1, un & 15, false, a->in[I_SINK] + l * 8, rope, wv);
                    else { const int r = un - GB * 32; attn_unit(lds, (const bf16_t*)(ws + WS_AQ), (const bf16_t*)(ws + WS_AK), (const bf16_t*)(ws + WS_AV), U, r >> 2, (r >> 1) & 1, r & 1, true, a->in[I_SINK] + l * 8, rope, wv); }
                }
            }
            GSYNC();
            { PHASE_ENV(1, 1);
              readout_phase(P, Hm, U, a->in[I_MNORM] + l * 512, last ? GLAT : GTOK, wv);
              pool_phase(P, U, !last, wv); }
            GSYNC();
            { PHASE_ENV(1, 1);
              pg8::Sched S; S.nseg = 1; S.G = G; S.c = bx; S.s0.A = (const char*)U; S.s0.Bt = (const char*)(wl + W_BR); S.s0.a_tile = (size_t)256 * 1536 * 2; S.s0.b_tile = (size_t)256 * 1536 * 2; S.s0.nM = last ? 128 : 144; S.s0.nN = 4; S.s0.nwg = S.s0.nM * S.s0.nN; S.s0.lat_n = 128; S.s0.a_lat = 0; S.s0.a_ctx = 128; S.s0.o_lat = 0; S.s0.o_ctx = 128; S.s0.pbmap = 0; S.s1 = S.s0;
              pg8::EpiMerge E{P, Y};
              pg8::gemm_phase<pg8::EpiMerge, 1536, 1536, 1536>(lds, S, E, wv); }
            GSYNC();
            { PHASE_ENV(1, 1);
              const float* xs_lat = l == 0 ? a->in[I_X] : a->out; const float* xs_ctx = l == 0 ? a->in[I_CTX] : ctxx;
              pg8::Sched S; S.nseg = 1; S.G = G; S.c = bx; S.s0.A = (const char*)Y; S.s0.Bt = (const char*)(wl + W_OUT); S.s0.a_tile = (size_t)256 * D * 2; S.s0.b_tile = (size_t)256 * D * 2; S.s0.nM = last ? 128 : 144; S.s0.nN = 4; S.s0.nwg = S.s0.nM * S.s0.nN; S.s0.lat_n = 128; S.s0.a_lat = 0; S.s0.a_ctx = 128; S.s0.o_lat = 128 * g; S.s0.o_ctx = 256 + 16 * g; S.s0.pbmap = 0; S.s1 = S.s0;
              pg8::EpiRes E{xs_lat, xs_ctx, a->out, ctxx, modl + 2048, l == 0 ? nullptr : (const float*)(ws + WS_STATS), a->in[I_LN2G], a->in[I_LN2B]};
              pg8::gemm_phase<pg8::EpiRes, D, D, D>(lds, S, E, wv); }
            GSYNC();
    }
    {
        { PHASE_ENV(1, 0);
          ln_pass(last ? NLAT : NTOK, a->out, ctxx, a->out, ctxx, a->in[I_LN1G] + l * D, a->in[I_LN1B] + l * D, modl, 3072, H, (float*)(ws + WS_STATS), wv); }
        GSYNC();
        { PHASE_ENV(1, 0);
          pg8::Sched S; S.nseg = 1; S.G = G; S.c = bx; S.s0.A = (const char*)H; S.s0.Bt = (const char*)(wl + W_GU); S.s0.a_tile = (size_t)256 * D * 2; S.s0.b_tile = (size_t)256 * D * 2; S.s0.nM = last ? 256 : 288; S.s0.nN = 22; S.s0.nwg = S.s0.nM * S.s0.nN; S.s0.lat_n = 1 << 20; S.s0.a_lat = 0; S.s0.a_ctx = 0; S.s0.o_lat = 0; S.s0.o_ctx = 0; S.s0.pbmap = 0; S.s1 = S.s0;
          pg8::EpiUp E{ACT};
          pg8::gemm_phase<pg8::EpiUp, D, D, D>(lds, S, E, wv); }
        GSYNC();
        { PHASE_ENV(1, 0);
          pg8::Sched S; S.nseg = 1; S.G = G; S.c = bx; S.s0.A = (const char*)ACT; S.s0.Bt = (const char*)(wl + W_DN); S.s0.a_tile = (size_t)256 * DFF * 2; S.s0.b_tile = (size_t)256 * DFF * 2; S.s0.nM = last ? 256 : 288; S.s0.nN = 4; S.s0.nwg = S.s0.nM * S.s0.nN; S.s0.lat_n = 1 << 20; S.s0.a_lat = 0; S.s0.a_ctx = 0; S.s0.o_lat = 0; S.s0.o_ctx = 0; S.s0.pbmap = 0; S.s1 = S.s0;
          pg8::EpiRes E{a->out, ctxx, a->out, ctxx, modl + 5120, (const float*)(ws + WS_STATS), a->in[I_LN1G] + l * D, a->in[I_LN1B] + l * D};
          pg8::gemm_phase<pg8::EpiRes, DFF, DFF, DFF>(lds, S, E, wv); }
        GSYNC();
        { PHASE_ENV(1, 0);
          ln_pass(last ? NLAT : NTOK, a->out, ctxx, a->out, ctxx, a->in[I_LN2G] + l * D, a->in[I_LN2B] + l * D, last ? nullptr : modl + (size_t)33 * 6144, 0, last ? nullptr : H, last ? nullptr : (float*)(ws + WS_STATS), wv); }
    }
}


extern "C" void kernel_launch(void* const* d_in, const int* in_sizes, int n_in, void* d_out, int out_size, void* d_ws, size_t ws_size, hipStream_t stream) {
    static int grid = 0;
    if (grid == 0) {
        if (n_in != 22 || ws_size < WS_END) { fprintf(stderr, "kernel_launch: unexpected n_in %d / ws %zu (need %zu)\n", n_in, ws_size, (size_t)WS_END); grid = -1; return; }
        int dev = 0, cus = 0, per_cu = 0;
        hipGetDevice(&dev);
        hipDeviceGetAttribute(&cus, hipDeviceAttributeMultiprocessorCount, dev);
        hipFuncSetAttribute((const void*)fwd_kernel, hipFuncAttributeMaxDynamicSharedMemorySize, LDS_BYTES);
        hipOccupancyMaxActiveBlocksPerMultiprocessor(&per_cu, (const void*)fwd_kernel, 512, LDS_BYTES);
        if (per_cu < 1) { fprintf(stderr, "kernel_launch: occupancy query says %d blocks/CU\n", per_cu); per_cu = 1; }
        (void)hipGetLastError();
        grid = cus;
        if (grid != 256) { fprintf(stderr, "kernel_launch: this kernel is laid out for a 256-CU device (got %d CUs); nothing launched\n", cus); grid = -1; return; }
    }
    if (grid < 0) return;
    hipMemsetAsync((char*)d_ws + WS_CTL, 0, CTL_BYTES, stream);
    Args a{};
    for (int i = 0; i < 22; ++i) a.in[i] = (const float*)d_in[i];
    a.out = (float*)d_out; a.ws = (unsigned char*)d_ws;
    void* args[] = {&a};
    hipError_t e = hipLaunchCooperativeKernel((const void*)fwd_kernel, dim3(grid), dim3(512), args, LDS_BYTES, stream);
    if (e != hipSuccess) fprintf(stderr, "cooperative launch failed: %s (grid %d)\n", hipGetErrorString(e), grid);
}
```
